# Optimizing an MI355X kernel written in HIP

```python
import jax, jax.numpy as jnp
from jax import lax
import numpy as np

D_MODEL = 1024
BATCH = 4
SEQ = 4096
DEPTH = 1

LRU_WIDTH = D_MODEL // 2
LRU_BLOCKS = 8
LRU_BLOCK_DIM = LRU_WIDTH // LRU_BLOCKS
CONV_WIDTH = 4
RG_C = 8.0
LRU_MIN_RAD = 0.9
LRU_MAX_RAD = 0.999
RET_HEADS = 8
RET_HEAD_DIM = 64
RET_WIDTH = RET_HEADS * RET_HEAD_DIM
CHUNK = 128
ROPE_BASE = 10000.0
D_FF = 4 * D_MODEL
EPS = 1e-6
IN_SPLITS = (LRU_WIDTH, LRU_WIDTH, RET_WIDTH, RET_WIDTH, RET_WIDTH, RET_WIDTH, D_MODEL, D_MODEL)
D_IN = sum(IN_SPLITS)

kernel_name = "hybrid_rglru_retention_gated_block"


def rmsnorm(x, g):
    xf = x.astype(jnp.float32)
    y = xf * lax.rsqrt(jnp.mean(xf * xf, axis=-1, keepdims=True) + EPS)
    return (y * g.astype(jnp.float32)).astype(x.dtype)


def causal_depthwise_conv(x, w, b):
    c = x.shape[-1]
    y = lax.conv_general_dilated(x, w[:, None, :], window_strides=(1,),
                                 padding=[(CONV_WIDTH - 1, 0)],
                                 dimension_numbers=("NWC", "WIO", "NWC"),
                                 feature_group_count=c)
    return y + b


def rg_lru(x, w_r, b_r, w_i, b_i, lam):
    bsz, s, w = x.shape
    xb = x.reshape(bsz, s, LRU_BLOCKS, LRU_BLOCK_DIM)
    r = jax.nn.sigmoid(jnp.einsum("bshd,hde->bshe", xb, w_r) + b_r).reshape(bsz, s, w)
    i = jax.nn.sigmoid(jnp.einsum("bshd,hde->bshe", xb, w_i) + b_i).reshape(bsz, s, w)
    log_a = -RG_C * r.astype(jnp.float32) * jax.nn.softplus(-lam.astype(jnp.float32))
    a = jnp.exp(log_a)
    mult = jnp.sqrt(-jnp.expm1(2.0 * log_a))
    u = mult * (i * x).astype(jnp.float32)

    def combine(c1, c2):
        a1, b1 = c1
        a2, b2 = c2
        return a1 * a2, a2 * b1 + b2

    _, h = lax.associative_scan(combine, (a, u), axis=1)
    return h.astype(x.dtype)


def rotary(x, pos):
    half = x.shape[-1] // 2
    inv = ROPE_BASE ** (-jnp.arange(half, dtype=jnp.float32) / half)
    ang = pos[:, None] * inv[None, :]
    cos = jnp.cos(ang)[None, :, None, :]
    sin = jnp.sin(ang)[None, :, None, :]
    xf = x.astype(jnp.float32)
    x1, x2 = xf[..., :half], xf[..., half:]
    return jnp.concatenate([x1 * cos - x2 * sin, x1 * sin + x2 * cos], axis=-1).astype(x.dtype)


def chunkwise_retention(q, k, v):
    bsz, s, nh, dh = q.shape
    n = s // CHUNK
    log_g = jnp.log1p(-jnp.exp2(-5.0 - jnp.arange(nh, dtype=jnp.float32)))
    pos = jnp.arange(CHUNK, dtype=jnp.float32)
    rel = pos[:, None] - pos[None, :]
    intra_decay = jnp.where(rel[None] >= 0,
                            jnp.exp(log_g[:, None, None] * jnp.maximum(rel, 0.0)[None]), 0.0)
    q_decay = jnp.exp(log_g[:, None] * (pos[None, :] + 1.0))
    k_decay = jnp.exp(log_g[:, None] * (CHUNK - 1.0 - pos[None, :]))
    chunk_decay = jnp.exp(log_g * CHUNK)
    qc = q.astype(jnp.float32).reshape(bsz, n, CHUNK, nh, dh)
    kc = k.astype(jnp.float32).reshape(bsz, n, CHUNK, nh, dh)
    vc = v.astype(jnp.float32).reshape(bsz, n, CHUNK, nh, dh)
    scores = jnp.einsum("bnchd,bnmhd->bnhcm", qc, kc) * intra_decay[None, None]
    intra = jnp.einsum("bnhcm,bnmhe->bnche", scores, vc)
    kv = jnp.einsum("bnchd,hc,bnche->bnhde", kc, k_decay, vc)

    def step(state, kv_i):
        return chunk_decay[None, :, None, None] * state + kv_i, state

    _, states = lax.scan(step, jnp.zeros((bsz, nh, dh, dh), jnp.float32), jnp.moveaxis(kv, 1, 0))
    states = jnp.moveaxis(states, 0, 1)
    inter = jnp.einsum("bnchd,hc,bnhde->bnche", qc, q_decay, states)
    return (intra + inter).reshape(bsz, s, nh, dh)


def setup_inputs(seed: int = 0) -> dict:
    key = jax.random.key(seed)
    ks = jax.random.split(key, 20)
    L = DEPTH

    def nrm(k, shape, fan_in):
        return jax.random.normal(k, shape, jnp.float32) * fan_in ** -0.5

    u = jax.random.uniform(ks[9], (L, LRU_WIDTH), jnp.float32)
    rad2 = u * (LRU_MAX_RAD ** 2 - LRU_MIN_RAD ** 2) + LRU_MIN_RAD ** 2
    a_real = 0.5 * jnp.log(rad2)
    lru_lambda = -jnp.log(jnp.expm1(-a_real))
    return {
        "x": jax.random.normal(ks[0], (BATCH, SEQ, D_MODEL), jnp.float32),
        "norm1_g": 1.0 + 0.05 * jax.random.normal(ks[1], (L, D_MODEL), jnp.float32),
        "w_in": nrm(ks[2], (L, D_MODEL, D_IN), D_MODEL),
        "conv_w": nrm(ks[3], (L, CONV_WIDTH, LRU_WIDTH), CONV_WIDTH),
        "conv_b": 0.02 * jax.random.normal(ks[4], (L, LRU_WIDTH), jnp.float32),
        "lru_wr": nrm(ks[5], (L, LRU_BLOCKS, LRU_BLOCK_DIM, LRU_BLOCK_DIM), LRU_BLOCK_DIM),
        "lru_br": 0.02 * jax.random.normal(ks[6], (L, LRU_BLOCKS, LRU_BLOCK_DIM), jnp.float32),
        "lru_wi": nrm(ks[7], (L, LRU_BLOCKS, LRU_BLOCK_DIM, LRU_BLOCK_DIM), LRU_BLOCK_DIM),
        "lru_bi": 0.02 * jax.random.normal(ks[8], (L, LRU_BLOCKS, LRU_BLOCK_DIM), jnp.float32),
        "lru_lambda": lru_lambda,
        "w_branch_a": nrm(ks[10], (L, LRU_WIDTH, D_MODEL), LRU_WIDTH),
        "w_branch_b": nrm(ks[11], (L, RET_WIDTH, D_MODEL), RET_WIDTH),
        "w_out": nrm(ks[12], (L, D_MODEL, D_MODEL), D_MODEL),
        "norm2_g": 1.0 + 0.05 * jax.random.normal(ks[13], (L, D_MODEL), jnp.float32),
        "w_ff1": nrm(ks[14], (L, D_MODEL, D_FF), D_MODEL),
        "w_ff2": nrm(ks[15], (L, D_FF, D_MODEL), D_FF),
        "norm_f_g": 1.0 + 0.05 * jax.random.normal(ks[16], (D_MODEL,), jnp.float32),
    }


def reference(x, norm1_g, w_in, conv_w, conv_b, lru_wr, lru_br, lru_wi, lru_bi, lru_lambda,
              w_branch_a, w_branch_b, w_out, norm2_g, w_ff1, w_ff2, norm_f_g):
    bsz, s, _ = x.shape
    pos = jnp.arange(s, dtype=jnp.float32)
    offsets = np.cumsum(np.array(IN_SPLITS))[:-1]
    for l in range(DEPTH):
        h = rmsnorm(x, norm1_g[l])
        proj = h @ w_in[l]
        xa, ga, q, k, v, gr, sa, sb = jnp.split(proj, offsets, axis=-1)
        xa = causal_depthwise_conv(xa, conv_w[l], conv_b[l])
        ya = jax.nn.gelu(ga) * rg_lru(xa, lru_wr[l], lru_br[l], lru_wi[l], lru_bi[l], lru_lambda[l])
        q = rotary(q.reshape(bsz, s, RET_HEADS, RET_HEAD_DIM), pos)
        k = rotary(k.reshape(bsz, s, RET_HEADS, RET_HEAD_DIM), pos) * (RET_HEAD_DIM ** -0.5)
        v = v.reshape(bsz, s, RET_HEADS, RET_HEAD_DIM)
        ret = chunkwise_retention(q, k, v)
        ret = ret * lax.rsqrt(jnp.mean(ret * ret, axis=-1, keepdims=True) + EPS)
        yb = jax.nn.silu(gr) * ret.reshape(bsz, s, RET_WIDTH).astype(x.dtype)
        m = jax.nn.sigmoid(sa) * (ya @ w_branch_a[l]) + jax.nn.sigmoid(sb) * (yb @ w_branch_b[l])
        x = x + m @ w_out[l]
        h2 = rmsnorm(x, norm2_g[l])
        x = x + jnp.square(jax.nn.relu(h2 @ w_ff1[l])) @ w_ff2[l]
    return rmsnorm(x, norm_f_g)
```

```cpp
#include <hip/hip_runtime.h>
#include <cstdio>
#include <cstdint>
#include <cmath>

typedef unsigned short bf16;
typedef unsigned v4u __attribute__((ext_vector_type(4)));
typedef float f32x4 __attribute__((ext_vector_type(4)));

constexpr int BATCH = 4, SEQ = 4096, D = 1024, T = BATCH * SEQ;
constexpr int LW = 512, NBLK = 8, BD = 64, RW = 512, NH = 8, HD = 64, FF = 4096, DIN = 5120;
constexpr float EPS = 1e-6f;
constexpr int C_XA = 0, C_GA = 512, C_Q = 1024, C_K = 1536, C_V = 2048, C_GR = 2560, C_SA = 3072, C_SB = 4096;

constexpr size_t MiB = 1u << 20;
constexpr size_t WS_CTL = 0;
constexpr size_t WS_ROPE = 1 * MiB;
constexpr size_t WS_WIN = 2 * MiB;
constexpr size_t WS_WAB = 12 * MiB;
constexpr size_t WS_WO = 14 * MiB;
constexpr size_t WS_W1 = 16 * MiB;
constexpr size_t WS_W2 = 24 * MiB;
constexpr size_t WS_XN = 32 * MiB;
constexpr size_t WS_XA = 64 * MiB;
constexpr size_t WS_GA = 96 * MiB;
constexpr size_t WS_Q = 112 * MiB, WS_K = 128 * MiB, WS_V = 144 * MiB, WS_GR = 160 * MiB;
constexpr size_t WS_SA = 176 * MiB, WS_SB = 208 * MiB;
constexpr size_t WS_ST = 240 * MiB;
constexpr size_t WS_YAB = WS_XN, WS_M = WS_XA, WS_H2 = WS_XN, WS_HB = 96 * MiB;
constexpr size_t WS_END = 256 * MiB;

__device__ __forceinline__ unsigned f2bf(float f) { unsigned u = __builtin_bit_cast(unsigned, f); return (u + 0x7fffu + ((u >> 16) & 1u)) >> 16; }
__device__ __forceinline__ float bf2f(unsigned short h) { return __builtin_bit_cast(float, (unsigned)h << 16); }
__device__ __forceinline__ float sigmoidf_(float x) { return 1.f / (1.f + __expf(-x)); }
__device__ __forceinline__ float gelu_tanh(float x) { const float u = 0.7978845608028654f * (x + 0.044715f * x * x * x); return 0.5f * x * (1.f + tanhf(u)); }

template <int PERM_QK>
__global__ void transpose_w(const float* __restrict__ W, int K, int N, bf16* __restrict__ WT, int ldk, int row_off, int k_off) {
    __shared__ float tile[32][33];
    const int n0 = blockIdx.x * 32, k0 = blockIdx.y * 32, tx = threadIdx.x, ty = threadIdx.y;
    for (int i = ty; i < 32; i += 8) {
        int nd = n0 + tx, ns = nd;
        if (PERM_QK && nd >= C_Q && nd < C_V) { const int j = nd & 63; ns = (nd & ~63) + (j >> 1) + 32 * (j & 1); }
        (void)ns;
        tile[i][tx] = W[(size_t)(k0 + i) * N + (PERM_QK ? ns : nd)];
    }
    __syncthreads();
    for (int i = ty; i < 32; i += 8) WT[(size_t)(row_off + n0 + i) * ldk + k_off + k0 + tx] = (bf16)f2bf(tile[tx][i]);
}
__global__ void rope_table(float2* __restrict__ tab) {
    const int idx = blockIdx.x * blockDim.x + threadIdx.x; if (idx >= SEQ * 32) return;
    const int pos = idx >> 5, i = idx & 31;
    const float inv = (float)pow(10000.0, -(double)i / 32.0);
    const float ang = (float)pos * inv;
    tab[idx] = make_float2((float)cos((double)ang), (float)sin((double)ang));
}
template <bool OUT_F32>
__global__ void rmsnorm_rows(const float* __restrict__ x, const float* __restrict__ g, bf16* __restrict__ ob, float* __restrict__ of) {
    const int lane = threadIdx.x & 63, row = blockIdx.x * 4 + (threadIdx.x >> 6);
    const f32x4* xr = (const f32x4*)(x + (size_t)row * D) + lane;
    f32x4 v[4]; float s = 0.f;
#pragma unroll
    for (int j = 0; j < 4; ++j) { v[j] = xr[64 * j]; s += (v[j].x * v[j].x + v[j].y * v[j].y) + (v[j].z * v[j].z + v[j].w * v[j].w); }
#pragma unroll
    for (int o = 1; o < 64; o <<= 1) s += __shfl_xor(s, o);
    const float rstd = 1.f / sqrtf(s * (1.f / D) + EPS);
#pragma unroll
    for (int j = 0; j < 4; ++j) {
        const f32x4 gg = ((const f32x4*)g)[lane + 64 * j];
        const f32x4 o = v[j] * rstd * gg;
        if (OUT_F32) ((f32x4*)(of + (size_t)row * D))[lane + 64 * j] = o;
        else { uint2 w; w.x = f2bf(o.x) | (f2bf(o.y) << 16); w.y = f2bf(o.z) | (f2bf(o.w) << 16); ((uint2*)(ob + (size_t)row * D))[lane + 64 * j] = w; }
    }
}

template <class Epi, bool DUAL>
__global__ void __launch_bounds__(256) gemm_naive(const bf16* __restrict__ A, const bf16* __restrict__ Bt, int M, int N, int K, Epi E) {
    __shared__ float As[32][68], Bs[32][68];
    const int tid = threadIdx.x, tx = tid & 15, ty = tid >> 4, m0 = blockIdx.y * 64, n0 = blockIdx.x * 64;
    const int lr = tid >> 2, lk = (tid & 3) * 8;
    float acc[2][4][4];
#pragma unroll
    for (int d = 0; d < 2; ++d)
#pragma unroll
        for (int i = 0; i < 4; ++i)
#pragma unroll
            for (int j = 0; j < 4; ++j) acc[d][i][j] = 0.f;
    for (int k0 = 0; k0 < K; k0 += 32) {
        const v4u av = *(const v4u*)(A + (size_t)(m0 + lr) * K + k0 + lk), bv = *(const v4u*)(Bt + (size_t)(n0 + lr) * K + k0 + lk);
        __syncthreads();
#pragma unroll
        for (int j = 0; j < 4; ++j) {
            As[lk + 2 * j][lr] = __builtin_bit_cast(float, av[j] << 16); As[lk + 2 * j + 1][lr] = __builtin_bit_cast(float, av[j] & 0xffff0000u);
            Bs[lk + 2 * j][lr] = __builtin_bit_cast(float, bv[j] << 16); Bs[lk + 2 * j + 1][lr] = __builtin_bit_cast(float, bv[j] & 0xffff0000u);
        }
        __syncthreads();
        const int d = (DUAL && k0 >= K / 2) ? 1 : 0;
#pragma unroll
        for (int kk = 0; kk < 32; ++kk) {
            const f32x4 a = *(const f32x4*)&As[kk][ty * 4], b = *(const f32x4*)&Bs[kk][tx * 4];
#pragma unroll
            for (int i = 0; i < 4; ++i)
#pragma unroll
                for (int j = 0; j < 4; ++j) { if (d == 0) acc[0][i][j] += a[i] * b[j]; else acc[1][i][j] += a[i] * b[j]; }
        }
    }
#pragma unroll
    for (int i = 0; i < 4; ++i)
#pragma unroll
        for (int j = 0; j < 4; j += 2) E(m0 + ty * 4 + i, n0 + tx * 4 + j, acc[0][i][j], acc[0][i][j + 1], acc[1][i][j], acc[1][i][j + 1]);
}

struct EpiProj {
    float* XA; bf16 *GA, *Q, *K, *V, *GR, *SA, *SB; const float2* rope;
    __device__ __forceinline__ void operator()(int r, int c, float v0, float v1, float, float) const {
        if (c < C_GA) { *(float2*)(XA + (size_t)r * LW + c) = make_float2(v0, v1); return; }
        bf16* dst; int cc; float o0, o1;
        if (c < C_Q) { dst = GA + (size_t)r * LW; cc = c - C_GA; o0 = gelu_tanh(v0); o1 = gelu_tanh(v1); }
        else if (c < C_V) {
            const bool isk = c >= C_K; dst = (isk ? K : Q) + (size_t)r * RW; cc = c - (isk ? C_K : C_Q);
            const float2 cs = rope[(r & (SEQ - 1)) * 32 + ((c & 63) >> 1)];
            o0 = v0 * cs.x - v1 * cs.y; o1 = v0 * cs.y + v1 * cs.x;
            if (isk) { o0 *= 0.125f; o1 *= 0.125f; }
        }
        else if (c < C_GR) { dst = V + (size_t)r * RW; cc = c - C_V; o0 = v0; o1 = v1; }
        else if (c < C_SA) { dst = GR + (size_t)r * RW; cc = c - C_GR; o0 = v0 * sigmoidf_(v0); o1 = v1 * sigmoidf_(v1); }
        else if (c < C_SB) { dst = SA + (size_t)r * D; cc = c - C_SA; o0 = sigmoidf_(v0); o1 = sigmoidf_(v1); }
        else { dst = SB + (size_t)r * D; cc = c - C_SB; o0 = sigmoidf_(v0); o1 = sigmoidf_(v1); }
        *(unsigned*)(dst + cc) = f2bf(o0) | (f2bf(o1) << 16);
    }
};
struct EpiMerge {
    const bf16 *SA, *SB; bf16* Mo;
    __device__ __forceinline__ void operator()(int r, int c, float a0, float a1, float b0, float b1) const {
        const unsigned sa = *(const unsigned*)(SA + (size_t)r * D + c), sb = *(const unsigned*)(SB + (size_t)r * D + c);
        const float o0 = bf2f(sa & 0xffff) * a0 + bf2f(sb & 0xffff) * b0, o1 = bf2f(sa >> 16) * a1 + bf2f(sb >> 16) * b1;
        *(unsigned*)(Mo + (size_t)r * D + c) = f2bf(o0) | (f2bf(o1) << 16);
    }
};
struct EpiResid {
    const float* base; float* out;
    __device__ __forceinline__ void operator()(int r, int c, float v0, float v1, float, float) const {
        const float2 b = *(const float2*)(base + (size_t)r * D + c);
        *(float2*)(out + (size_t)r * D + c) = make_float2(b.x + v0, b.y + v1);
    }
};
struct EpiRelu2 {
    bf16* H;
    __device__ __forceinline__ void operator()(int r, int c, float v0, float v1, float, float) const {
        const float a = fmaxf(v0, 0.f), b = fmaxf(v1, 0.f);
        *(unsigned*)(H + (size_t)r * FF + c) = f2bf(a * a) | (f2bf(b * b) << 16);
    }
};

__global__ void __launch_bounds__(64) lru_naive(const float* __restrict__ XA, const bf16* __restrict__ GA, const float* __restrict__ conv_w, const float* __restrict__ conv_b,
                                                const float* __restrict__ wr, const float* __restrict__ br, const float* __restrict__ wi, const float* __restrict__ bi,
                                                const float* __restrict__ lam, bf16* __restrict__ YAB) {
    __shared__ float Wr[64][64], Wi[64][64], xs[64];
    const int b = blockIdx.x >> 3, h = blockIdx.x & 7, e = threadIdx.x, c = h * 64 + e;
    for (int d = 0; d < 64; ++d) { Wr[d][e] = wr[(size_t)(h * 64 + d) * 64 + e]; Wi[d][e] = wi[(size_t)(h * 64 + d) * 64 + e]; }
    const float w0 = conv_w[0 * LW + c], w1 = conv_w[1 * LW + c], w2 = conv_w[2 * LW + c], w3 = conv_w[3 * LW + c], cb = conv_b[c];
    const float bre = br[c], bie = bi[c];
    const float sp = log1pf(expf(-lam[c]));
    float x1 = 0.f, x2 = 0.f, x3 = 0.f, hs = 0.f;
    __syncthreads();
    for (int t = 0; t < SEQ; ++t) {
        const size_t row = (size_t)b * SEQ + t;
        const float x0 = XA[row * LW + c];
        const float xc = w3 * x0 + w2 * x1 + w1 * x2 + w0 * x3 + cb;
        x3 = x2; x2 = x1; x1 = x0;
        xs[e] = xc;
        __syncthreads();
        float pr = bre, pi = bie;
#pragma unroll 8
        for (int d = 0; d < 64; ++d) { const float xd = xs[d]; pr += xd * Wr[d][e]; pi += xd * Wi[d][e]; }
        __syncthreads();
        const float r = 1.f / (1.f + expf(-pr)), ig = 1.f / (1.f + expf(-pi));
        const float la = -8.f * r * sp, a = expf(la), mult = sqrtf(-expm1f(2.f * la));
        hs = a * hs + mult * (ig * xc);
        YAB[row * D + c] = (bf16)f2bf(bf2f(GA[row * LW + c]) * hs);
    }
}
__global__ void __launch_bounds__(256) ret_naive(const bf16* __restrict__ Q, const bf16* __restrict__ Kk, const bf16* __restrict__ V, const bf16* __restrict__ GR, bf16* __restrict__ YAB) {
    __shared__ float qs[64], ks[64], vs[64], red[4][64];
    const int b = blockIdx.x >> 3, h = blockIdx.x & 7, tid = threadIdx.x, e = tid & 63, dg = tid >> 6;
    const float gamma = 1.f - exp2f(-5.f - (float)h);
    float S[16];
#pragma unroll
    for (int j = 0; j < 16; ++j) S[j] = 0.f;
    for (int t = 0; t < SEQ; ++t) {
        const size_t row = (size_t)b * SEQ + t;
        if (dg == 0) qs[e] = bf2f(Q[row * RW + h * 64 + e]); else if (dg == 1) ks[e] = bf2f(Kk[row * RW + h * 64 + e]); else if (dg == 2) vs[e] = bf2f(V[row * RW + h * 64 + e]);
        __syncthreads();
        const float ve = vs[e]; float p = 0.f;
#pragma unroll
        for (int j = 0; j < 16; ++j) { S[j] = gamma * S[j] + ks[dg * 16 + j] * ve; p += qs[dg * 16 + j] * S[j]; }
        red[dg][e] = p;
        __syncthreads();
        if (dg == 0) {
            const float ret = (red[0][e] + red[1][e]) + (red[2][e] + red[3][e]);
            float s = ret * ret;
#pragma unroll
            for (int o = 1; o < 64; o <<= 1) s += __shfl_xor(s, o);
            const float y = ret * (1.f / sqrtf(s * (1.f / 64.f) + EPS)) * bf2f(GR[row * RW + h * 64 + e]);
            YAB[row * D + LW + h * 64 + e] = (bf16)f2bf(y);
        }
    }
}

extern "C" void kernel_launch(void* const* d_in, const int* in_sizes, int n_in, void* d_out, int out_size, void* d_ws, size_t ws_size, hipStream_t stream) {
    if (n_in != 17 || in_sizes[0] != T * D || out_size != T * D || ws_size < WS_END) { fprintf(stderr, "kernel_launch: unexpected shapes (n_in %d, in0 %d, out %d, ws %zu)\n", n_in, n_in > 0 ? in_sizes[0] : -1, out_size, ws_size); return; }
    const float* x = (const float*)d_in[0]; const float* g1 = (const float*)d_in[1]; const float* w_in = (const float*)d_in[2];
    const float* conv_w = (const float*)d_in[3]; const float* conv_b = (const float*)d_in[4];
    const float* wr = (const float*)d_in[5]; const float* br = (const float*)d_in[6]; const float* wi = (const float*)d_in[7]; const float* bi = (const float*)d_in[8];
    const float* lam = (const float*)d_in[9]; const float* w_a = (const float*)d_in[10]; const float* w_b = (const float*)d_in[11]; const float* w_out = (const float*)d_in[12];
    const float* g2 = (const float*)d_in[13]; const float* w1 = (const float*)d_in[14]; const float* w2 = (const float*)d_in[15]; const float* gf = (const float*)d_in[16];
    float* out = (float*)d_out; unsigned char* ws = (unsigned char*)d_ws;
    bf16 *WinT = (bf16*)(ws + WS_WIN), *WabT = (bf16*)(ws + WS_WAB), *WoT = (bf16*)(ws + WS_WO), *W1T = (bf16*)(ws + WS_W1), *W2T = (bf16*)(ws + WS_W2);
    bf16 *XN = (bf16*)(ws + WS_XN), *GA = (bf16*)(ws + WS_GA), *Q = (bf16*)(ws + WS_Q), *Kb = (bf16*)(ws + WS_K), *V = (bf16*)(ws + WS_V), *GR = (bf16*)(ws + WS_GR);
    bf16 *SA = (bf16*)(ws + WS_SA), *SB = (bf16*)(ws + WS_SB), *YAB = (bf16*)(ws + WS_YAB), *Mb = (bf16*)(ws + WS_M), *H2 = (bf16*)(ws + WS_H2), *HB = (bf16*)(ws + WS_HB);
    float* XA = (float*)(ws + WS_XA); float2* rope = (float2*)(ws + WS_ROPE);
    const dim3 tb(32, 8);
    transpose_w<1><<<dim3(DIN / 32, D / 32), tb, 0, stream>>>(w_in, D, DIN, WinT, D, 0, 0);
    transpose_w<0><<<dim3(D / 32, LW / 32), tb, 0, stream>>>(w_a, LW, D, WabT, D, 0, 0);
    transpose_w<0><<<dim3(D / 32, RW / 32), tb, 0, stream>>>(w_b, RW, D, WabT, D, 0, LW);
    transpose_w<0><<<dim3(D / 32, D / 32), tb, 0, stream>>>(w_out, D, D, WoT, D, 0, 0);
    transpose_w<0><<<dim3(FF / 32, D / 32), tb, 0, stream>>>(w1, D, FF, W1T, D, 0, 0);
    transpose_w<0><<<dim3(D / 32, FF / 32), tb, 0, stream>>>(w2, FF, D, W2T, FF, 0, 0);
    rope_table<<<SEQ * 32 / 256, 256, 0, stream>>>(rope);
    rmsnorm_rows<false><<<T / 4, 256, 0, stream>>>(x, g1, XN, nullptr);
    gemm_naive<EpiProj, false><<<dim3(DIN / 64, T / 64), 256, 0, stream>>>(XN, WinT, T, DIN, D, EpiProj{XA, GA, Q, Kb, V, GR, SA, SB, rope});
    lru_naive<<<BATCH * NBLK, 64, 0, stream>>>(XA, GA, conv_w, conv_b, wr, br, wi, bi, lam, YAB);
    ret_naive<<<BATCH * NH, 256, 0, stream>>>(Q, Kb, V, GR, YAB);
    gemm_naive<EpiMerge, true><<<dim3(D / 64, T / 64), 256, 0, stream>>>(YAB, WabT, T, D, D, EpiMerge{SA, SB, Mb});
    gemm_naive<EpiResid, false><<<dim3(D / 64, T / 64), 256, 0, stream>>>(Mb, WoT, T, D, D, EpiResid{x, out});
    rmsnorm_rows<false><<<T / 4, 256, 0, stream>>>(out, g2, H2, nullptr);
    gemm_naive<EpiRelu2, false><<<dim3(FF / 64, T / 64), 256, 0, stream>>>(H2, W1T, T, FF, D, EpiRelu2{HB});
    gemm_naive<EpiResid, false><<<dim3(D / 64, T / 64), 256, 0, stream>>>(HB, W2T, T, D, FF, EpiResid{out, out});
    rmsnorm_rows<true><<<T / 4, 256, 0, stream>>>(out, gf, nullptr, out);
}
```

```cpp
#include <hip/hip_runtime.h>
#include <cstdio>
#include <cstdint>
#include <cmath>
namespace pg8 {
#define PG8_LAS __attribute__((address_space(3)))
typedef unsigned short bf16_t;
typedef short bf16x8 __attribute__((ext_vector_type(8)));
typedef float f32x4 __attribute__((ext_vector_type(4)));
typedef unsigned u32x4 __attribute__((ext_vector_type(4)));
constexpr int BM = 256, BK = 64, HALF = 128, HTB = HALF * BK * 2  , STAGE_BYTES = 8 * HTB, NXCD = 8, WGM = 8;

__host__ __device__ __forceinline__ int lds_byte(int r, int c) { const int st = (r >> 4) * 2 + (c >> 5), rr = r & 15, cc = c & 31, ob = rr * 64 + cc * 2; return st * 1024 + (ob ^ (((ob >> 9) & 1) << 5)); }
__host__ __device__ __forceinline__ void stage_rc(int b, int& R, int& C) { const int st = b / 1024, sb = b % 1024, swz = sb ^ (((sb >> 9) & 1) << 5); R = (st >> 1) * 16 + swz / 64; C = (st & 1) * 32 + (swz % 64) / 2; }
__host__ __device__ __forceinline__ int perm32(int rho) { const int n = rho >> 4, i = rho & 15; return 8 * (i >> 2) + 4 * n + (i & 3); }

struct Unit { int pm, pn, kh; };
struct Gemm { const bf16_t* A; const bf16_t* Bt; int M, N, K, ld; };

struct StaticOrder {
    int nM, nN, nwg, G, c;
    __host__ __device__ void init(int M, int N, int G_, int c_) { nM = M / BM; nN = N / BM; nwg = nM * nN; G = G_; c = c_; }
    __host__ __device__ bool next(int i, Unit& u) const {
        const long L = (long)i * G + c; if (L >= nwg) return false;
        int wgid = (int)L; { const int q = nwg / NXCD, r = nwg % NXCD, xcd = wgid % NXCD, off = wgid / NXCD; wgid = (xcd < r ? xcd * (q + 1) : r * (q + 1) + (xcd - r) * q) + off; }
        const int nig = WGM * nN, gid = wgid / nig, fm = gid * WGM, gsz = (nM - fm) < WGM ? (nM - fm) : WGM;
        u.pm = fm + ((wgid % nig) % gsz); u.pn = (wgid % nig) / gsz; u.kh = 0; return true;
    }
    __device__ __forceinline__ void a_ready(const Unit&) const {}
    __device__ __forceinline__ void done(const Unit&) const {}
};
struct PairOrder : StaticOrder {
    __host__ __device__ bool next(int i, Unit& u) const { if (!StaticOrder::next(i >> 1, u)) return false; u.kh = i & 1; return true; }
};
struct OneUnitOrder : StaticOrder {
    int sel;
    __host__ __device__ bool next(int i, Unit& u) const { if (i != 0) return false; return StaticOrder::next(sel, u); }
};
typedef float f32x2_t __attribute__((ext_vector_type(2))); typedef __bf16 bf16x2_t __attribute__((ext_vector_type(2)));
__device__ __forceinline__ unsigned cvt_pk_bf16(float lo, float hi) { f32x2_t v = {lo, hi}; bf16x2_t b = __builtin_convertvector(v, bf16x2_t); return __builtin_bit_cast(unsigned, b); }
template <class Epi, class Sched, bool ALIGN_EPI = false, bool SP2 = false>
__device__ __forceinline__ void gemm_phase(PG8_LAS unsigned char* lds, const Gemm g, const Sched& S, const Epi& E) {
    const int tid = threadIdx.x, wid = __builtin_amdgcn_readfirstlane(tid >> 6), lane = tid & 63, wr = wid >> 2, wc = wid & 3, fr = lane & 15, fq = lane >> 4;
    const int K = g.K, LD = g.ld, nt = K / BK;
    unsigned voffA[2], voffB[2];
#pragma unroll
    for (int i = 0; i < 2; ++i) { int R, C; stage_rc(tid * 16 + i * 8192, R, C); const int Rb = Epi::PERM ? ((R & ~31) + perm32(R & 31)) : R;
        voffA[i] = (unsigned)(R * LD + C) * 2u; voffB[i] = (unsigned)(Rb * LD + C) * 2u; }
    const size_t kstep = (size_t)(BK * 2);
    const size_t hstep = (size_t)HALF * LD * 2;
    const size_t tstep = 2 * hstep;
    const unsigned ldsw = (unsigned)wid * 1024u;
    const int aoff = lds_byte(wr * 64 + fr, fq * 8), boff = lds_byte(wc * 32 + fr, fq * 8);
#define PG8_SA(b, h) (((b) * 2 + (h)) * HTB)
#define PG8_SB(b, h) ((4 + (b) * 2 + (h)) * HTB)
#define PG8_STAGE(bufoff, gbase, voff) do { _Pragma("unroll") for (int _i = 0; _i < 2; ++_i) \
        __builtin_amdgcn_global_load_lds((const unsigned*)((const char*)(gbase) + (voff)[_i]), (PG8_LAS unsigned*)(lds + (bufoff) + ldsw + _i * 8192), 16, 0, 0); } while (0)
#define PG8_LDA(dst, b, h) do { _Pragma("unroll") for (int m = 0; m < 4; ++m) _Pragma("unroll") for (int k = 0; k < 2; ++k) dst[m][k] = *(const PG8_LAS bf16x8*)(lds + PG8_SA(b, h) + aoff + m * 2048 + k * 1024); } while (0)
#define PG8_LDB(dst, b, h) do { _Pragma("unroll") for (int n = 0; n < 2; ++n) _Pragma("unroll") for (int k = 0; k < 2; ++k) dst[n][k] = *(const PG8_LAS bf16x8*)(lds + PG8_SB(b, h) + boff + n * 2048 + k * 1024); } while (0)
#define PG8_MMA(ai, bj, At, Bt) do { __builtin_amdgcn_s_setprio(1); _Pragma("unroll") for (int m = 0; m < 4; ++m) _Pragma("unroll") for (int n = 0; n < 2; ++n) _Pragma("unroll") for (int k = 0; k < 2; ++k) \
        acc[ai][bj][m][n] = __builtin_amdgcn_mfma_f32_16x16x32_bf16(Bt[n][k], At[m][k], acc[ai][bj][m][n], 0, 0, 0); __builtin_amdgcn_s_setprio(0); } while (0)
#define PG8_WAIT_V(n) asm volatile("s_waitcnt vmcnt(" #n ")" ::: "memory")
#define PG8_WAIT_L(n) asm volatile("s_waitcnt lgkmcnt(" #n ")" ::: "memory")
#define PG8_BAR __builtin_amdgcn_s_barrier()
#define PG8_SCHED __builtin_amdgcn_sched_barrier(0)
    Unit cur, nxt; int ui = 0;
    if (!S.next(0, cur)) return;
    f32x4 acc[2][2][4][2];
#pragma unroll
    for (int a = 0; a < 2; ++a)
#pragma unroll
        for (int b = 0; b < 2; ++b)
#pragma unroll
            for (int m = 0; m < 4; ++m)
#pragma unroll
                for (int n = 0; n < 2; ++n) acc[a][b][m][n] = (f32x4){0.f, 0.f, 0.f, 0.f};
    bf16x8 At[4][2], B0[2][2], B1[2][2];
    const size_t khstep = (size_t)K * 2;
    const char* cA = (const char*)g.A + (size_t)cur.pm * tstep + (size_t)cur.kh * khstep; const char* cB = (const char*)g.Bt + (size_t)cur.pn * tstep + (size_t)cur.kh * khstep;
    S.a_ready(cur);
    if constexpr (SP2) {
        PG8_STAGE(PG8_SB(0, 0), cB, voffB); PG8_STAGE(PG8_SB(0, 1), cB + hstep, voffB); PG8_STAGE(PG8_SA(0, 0), cA, voffA); PG8_STAGE(PG8_SA(0, 1), cA + hstep, voffA);
        if (wr == 1) PG8_BAR;
        PG8_WAIT_V(2); PG8_BAR;
        PG8_STAGE(PG8_SB(1, 0), cB + kstep, voffB); PG8_STAGE(PG8_SA(1, 0), cA + kstep, voffA); PG8_STAGE(PG8_SB(1, 1), cB + hstep + kstep, voffB);
        PG8_WAIT_V(6); PG8_BAR;
    } else {
        PG8_STAGE(PG8_SB(0, 0), cB, voffB); PG8_STAGE(PG8_SA(0, 0), cA, voffA); PG8_STAGE(PG8_SB(0, 1), cB + hstep, voffB); PG8_STAGE(PG8_SA(0, 1), cA + hstep, voffA);
        if (wr == 1) PG8_BAR;
        PG8_WAIT_V(4); PG8_BAR;
        PG8_STAGE(PG8_SB(1, 0), cB + kstep, voffB); PG8_STAGE(PG8_SA(1, 0), cA + kstep, voffA); PG8_STAGE(PG8_SB(1, 1), cB + hstep + kstep, voffB);
        PG8_WAIT_V(6); PG8_BAR;
    }
    for (;;) {
        const bool has_next = S.next(ui + 1, nxt);
        const char* nA = has_next ? (const char*)g.A + (size_t)nxt.pm * tstep + (size_t)nxt.kh * khstep : cA; const char* nB = has_next ? (const char*)g.Bt + (size_t)nxt.pn * tstep + (size_t)nxt.kh * khstep : cB;
        for (int t = 0; t < nt; t += 2) {
            const bool last = (t == nt - 2);
            const char* a1 = cA + (size_t)(t + 1) * kstep;
            const char* a2 = last ? nA : cA + (size_t)(t + 2) * kstep; const char* b2 = last ? nB : cB + (size_t)(t + 2) * kstep;
            const char* a3 = a2 + kstep; const char* b3 = b2 + kstep;
            if (last && has_next) S.a_ready(nxt);
            if constexpr (SP2) {
            PG8_LDB(B0, 0, 0); PG8_LDB(B1, 0, 1); PG8_SCHED; PG8_LDA(At, 0, 0); PG8_STAGE(PG8_SA(1, 1), a1 + hstep, voffA);
            PG8_WAIT_V(8); PG8_WAIT_L(0); PG8_BAR; PG8_MMA(0, 0, At, B0); PG8_MMA(0, 1, At, B1); PG8_BAR; PG8_SCHED;
            PG8_LDA(At, 0, 1); PG8_STAGE(PG8_SB(0, 0), b2, voffB); PG8_STAGE(PG8_SB(0, 1), b2 + hstep, voffB); PG8_STAGE(PG8_SA(0, 0), a2, voffA);
            PG8_WAIT_V(8); PG8_WAIT_L(0); PG8_BAR; PG8_MMA(1, 0, At, B0); PG8_MMA(1, 1, At, B1); PG8_BAR; PG8_SCHED;
            PG8_LDB(B0, 1, 0); PG8_LDB(B1, 1, 1); PG8_SCHED; PG8_LDA(At, 1, 0); PG8_STAGE(PG8_SA(0, 1), a2 + hstep, voffA);
            PG8_WAIT_V(8); PG8_WAIT_L(0); PG8_BAR; PG8_MMA(0, 0, At, B0); PG8_MMA(0, 1, At, B1); PG8_BAR; PG8_SCHED;
            PG8_LDA(At, 1, 1); PG8_STAGE(PG8_SB(1, 0), b3, voffB); PG8_STAGE(PG8_SB(1, 1), b3 + hstep, voffB); PG8_STAGE(PG8_SA(1, 0), a3, voffA);
            PG8_WAIT_V(8); PG8_WAIT_L(0); PG8_BAR; PG8_MMA(1, 0, At, B0); PG8_MMA(1, 1, At, B1); PG8_BAR; PG8_SCHED;
            } else {
            PG8_LDB(B0, 0, 0); PG8_SCHED; PG8_LDA(At, 0, 0); PG8_STAGE(PG8_SA(1, 1), a1 + hstep, voffA);
            PG8_WAIT_L(8); PG8_BAR; PG8_WAIT_L(0); PG8_MMA(0, 0, At, B0); PG8_BAR; PG8_SCHED;
            PG8_LDB(B1, 0, 1); PG8_STAGE(PG8_SB(0, 0), b2, voffB);
            PG8_BAR; PG8_WAIT_L(0); PG8_MMA(0, 1, At, B1); PG8_BAR;
            PG8_LDA(At, 0, 1); PG8_STAGE(PG8_SA(0, 0), a2, voffA);
            PG8_BAR; PG8_WAIT_L(0); PG8_MMA(1, 0, At, B0); PG8_BAR; PG8_SCHED;
            PG8_STAGE(PG8_SB(0, 1), b2 + hstep, voffB);
            PG8_WAIT_V(6); PG8_BAR; PG8_MMA(1, 1, At, B1); PG8_BAR;
            PG8_LDB(B0, 1, 0); PG8_SCHED; PG8_LDA(At, 1, 0); PG8_STAGE(PG8_SA(0, 1), a2 + hstep, voffA);
            PG8_WAIT_L(8); PG8_BAR; PG8_WAIT_L(0); PG8_MMA(0, 0, At, B0); PG8_BAR; PG8_SCHED;
            PG8_LDB(B1, 1, 1); PG8_STAGE(PG8_SB(1, 0), b3, voffB);
            PG8_BAR; PG8_WAIT_L(0); PG8_MMA(0, 1, At, B1); PG8_BAR;
            PG8_LDA(At, 1, 1); PG8_STAGE(PG8_SA(1, 0), a3, voffA);
            PG8_BAR; PG8_WAIT_L(0); PG8_MMA(1, 0, At, B0); PG8_BAR; PG8_SCHED;
            PG8_STAGE(PG8_SB(1, 1), b3 + hstep, voffB);
            PG8_WAIT_V(6); PG8_BAR; PG8_MMA(1, 1, At, B1); PG8_BAR;
            }
        }
        if constexpr (ALIGN_EPI) { if (wr == 0) PG8_BAR; }
        bool chain = false;
        if constexpr (Epi::HAS_MID) { if (cur.kh == 0) { E.mid(acc, cur, wr, wc, fr, fq); chain = true; } }
        if constexpr (!Epi::AFTER_DRAIN) { if (!chain) { E(acc, cur, wr, wc, fr, fq); S.done(cur); } }
        if (!has_next) break;
        if (!chain) {
#pragma unroll
        for (int a = 0; a < 2; ++a)
#pragma unroll
            for (int b = 0; b < 2; ++b)
#pragma unroll
                for (int m = 0; m < 4; ++m)
#pragma unroll
                    for (int n = 0; n < 2; ++n) acc[a][b][m][n] = (f32x4){0.f, 0.f, 0.f, 0.f};
        }
        cur = nxt; cA = nA; cB = nB; ++ui;
        if constexpr (ALIGN_EPI) { if (wr == 1) PG8_BAR; }
    }
    PG8_WAIT_V(0);
    if constexpr (!ALIGN_EPI) { if (wr == 0) PG8_BAR; }
    PG8_BAR;
    if constexpr (Epi::AFTER_DRAIN) { E.fused(acc, cur, wr, wc, fr, fq, lds, wid, lane); S.done(cur); }
#undef PG8_SA
#undef PG8_SB
#undef PG8_STAGE
#undef PG8_LDA
#undef PG8_LDB
#undef PG8_MMA
#undef PG8_WAIT_V
#undef PG8_WAIT_L
#undef PG8_BAR
#undef PG8_SCHED
}
}
namespace pg8 {
typedef unsigned u32x2 __attribute__((ext_vector_type(2)));
constexpr int SEQ_ = 4096;
__device__ __forceinline__ float fsig(float x) { return __builtin_amdgcn_rcpf(1.f + __expf(-x)); }
__device__ __forceinline__ float fgelu(float x) { return x * fsig(1.5957691216057308f * (x + 0.044715f * x * x * x)); }
__device__ __forceinline__ u32x4 pack8(const f32x4 a, const f32x4 b) { u32x4 w; w.x = cvt_pk_bf16(a[0], a[1]); w.y = cvt_pk_bf16(a[2], a[3]); w.z = cvt_pk_bf16(b[0], b[1]); w.w = cvt_pk_bf16(b[2], b[3]); return w; }
__device__ __forceinline__ float bflo(unsigned w) { return __builtin_bit_cast(float, w << 16); }
__device__ __forceinline__ float bfhi(unsigned w) { return __builtin_bit_cast(float, w & 0xffff0000u); }

template <bool QSCALE> struct EpiProj {
    static constexpr bool PERM = true, AFTER_DRAIN = false, HAS_MID = false;
    float* XA; bf16_t *GA, *Q, *K, *V, *GR, *SA, *SB; const float* rope; float lg2g[8];
    __device__ __forceinline__ void operator()(const f32x4 (&acc)[2][2][4][2], const Unit& u, int wr, int wc, int fr, int fq) const {
        const int pn = u.pn, row0 = u.pm * BM + wr * 64 + fr, ct = wc * 32 + 8 * fq;
        if (pn < 2) {
#pragma unroll
            for (int ai = 0; ai < 2; ++ai)
#pragma unroll
                for (int m = 0; m < 4; ++m) { float* rowp = XA + (size_t)(row0 + ai * HALF + m * 16) * 512 + pn * BM + ct;
#pragma unroll
                    for (int bj = 0; bj < 2; ++bj) { *(f32x4*)(rowp + bj * HALF) = acc[ai][bj][m][0]; *(f32x4*)(rowp + bj * HALF + 4) = acc[ai][bj][m][1]; } }
        } else if (pn >= 4 && pn < 8) {
            const bool isk = pn >= 6; bf16_t* dst = isk ? K : Q; const int cb = (pn & 1) * BM + ct, d0 = (ct & 63) >> 1;
            float lgh[2] = {0.f, 0.f};
            if (QSCALE) {
#pragma unroll
                for (int bj = 0; bj < 2; ++bj) { const int h = (pn & 1) * 4 + bj * 2 + (wc >> 1);
#pragma unroll
                    for (int k = 0; k < 8; ++k) lgh[bj] = (h == k) ? lg2g[k] : lgh[bj]; } }
#pragma unroll
            for (int ai = 0; ai < 2; ++ai)
#pragma unroll
                for (int m = 0; m < 4; ++m) { const int row = row0 + ai * HALF + m * 16; const float* rp = rope + ((size_t)(row & (SEQ_ - 1)) * 32 + d0) * 2;
                    const f32x4 cs0 = *(const f32x4*)rp, cs1 = *(const f32x4*)(rp + 4);
#pragma unroll
                    for (int bj = 0; bj < 2; ++bj) { const f32x4 a = acc[ai][bj][m][0], b = acc[ai][bj][m][1]; f32x4 o0, o1;
                        float sc = isk ? 0.125f : 1.f;
                        if (QSCALE) { const float e = (float)((row & 127) + 1) * lgh[bj]; sc *= __builtin_amdgcn_exp2f(isk ? -e : e); }
                        o0[0] = (a[0] * cs0[0] - a[1] * cs0[1]) * sc; o0[1] = (a[0] * cs0[1] + a[1] * cs0[0]) * sc; o0[2] = (a[2] * cs0[2] - a[3] * cs0[3]) * sc; o0[3] = (a[2] * cs0[3] + a[3] * cs0[2]) * sc;
                        o1[0] = (b[0] * cs1[0] - b[1] * cs1[1]) * sc; o1[1] = (b[0] * cs1[1] + b[1] * cs1[0]) * sc; o1[2] = (b[2] * cs1[2] - b[3] * cs1[3]) * sc; o1[3] = (b[2] * cs1[3] + b[3] * cs1[2]) * sc;
                        *(u32x4*)(dst + (size_t)row * 512 + cb + bj * HALF) = pack8(o0, o1); }
                    __builtin_amdgcn_sched_barrier(0); }
        } else {
            const bool isga = pn < 4, isv = pn >= 8 && pn < 10, issig = pn >= 12;
            bf16_t* dst = (bf16_t*)((unsigned char*)GA + ((size_t)(48 * (pn >= 8) + 16 * (pn >= 10) + 16 * (pn >= 12) + 32 * (pn >= 16)) << 20));
            const int ldc = issig ? 1024 : 512, col0 = (isga ? (pn - 2) : isv ? (pn - 8) : pn < 12 ? (pn - 10) : ((pn - 12) & 3)) * BM + ct;
            const float c3 = isga ? 0.044715f * 1.5957691216057308f : 0.f, c1 = isga ? 1.5957691216057308f : 1.f;
#pragma unroll
            for (int ai = 0; ai < 2; ++ai)
#pragma unroll
                for (int m = 0; m < 4; ++m) { bf16_t* rowp = dst + (size_t)(row0 + ai * HALF + m * 16) * ldc + col0;
#pragma unroll
                    for (int bj = 0; bj < 2; ++bj) { f32x4 v[2] = {acc[ai][bj][m][0], acc[ai][bj][m][1]};
#pragma unroll
                        for (int n = 0; n < 2; ++n)
#pragma unroll
                            for (int e = 0; e < 4; ++e) { const float x = v[n][e], z = x * (c1 + c3 * x * x), sg = fsig(z); v[n][e] = (issig ? 1.f : x) * (isv ? 1.f : sg); }
                        *(u32x4*)(rowp + bj * HALF) = pack8(v[0], v[1]); }
                    __builtin_amdgcn_sched_barrier(0); }
        }
    }
};
struct EpiMerge {
    static constexpr bool PERM = true, AFTER_DRAIN = false, HAS_MID = true;
    const bf16_t *SA, *SB; bf16_t* Mo;
    __device__ __forceinline__ void mid(f32x4 (&acc)[2][2][4][2], const Unit& u, int wr, int wc, int fr, int fq) const {
        const int row0 = u.pm * BM + wr * 64 + fr, col0 = u.pn * BM + wc * 32 + 8 * fq;
#pragma unroll
        for (int ai = 0; ai < 2; ++ai)
#pragma unroll
            for (int m = 0; m < 4; ++m) { const size_t off = (size_t)(row0 + ai * HALF + m * 16) * 1024 + col0;
#pragma unroll
                for (int bj = 0; bj < 2; ++bj) { const u32x4 a = *(const u32x4*)(SA + off + bj * HALF), b = *(const u32x4*)(SB + off + bj * HALF);
#pragma unroll
                    for (int e = 0; e < 4; ++e) { const float r0 = bflo(a[e]) * __builtin_amdgcn_rcpf(fmaxf(bflo(b[e]), 1e-30f)), r1 = bfhi(a[e]) * __builtin_amdgcn_rcpf(fmaxf(bfhi(b[e]), 1e-30f));
                        acc[ai][bj][m][e >> 1][2 * (e & 1)] *= r0; acc[ai][bj][m][e >> 1][2 * (e & 1) + 1] *= r1; } }
                __builtin_amdgcn_sched_barrier(0); }
    }
    __device__ __forceinline__ void operator()(const f32x4 (&acc)[2][2][4][2], const Unit& u, int wr, int wc, int fr, int fq) const {
        const int row0 = u.pm * BM + wr * 64 + fr, col0 = u.pn * BM + wc * 32 + 8 * fq;
#pragma unroll
        for (int ai = 0; ai < 2; ++ai)
#pragma unroll
            for (int m = 0; m < 4; ++m) { const size_t off = (size_t)(row0 + ai * HALF + m * 16) * 1024 + col0;
#pragma unroll
                for (int bj = 0; bj < 2; ++bj) { const u32x4 b = *(const u32x4*)(SB + off + bj * HALF); f32x4 v0 = acc[ai][bj][m][0], v1 = acc[ai][bj][m][1];
                    v0[0] *= fmaxf(bflo(b[0]), 1e-30f); v0[1] *= fmaxf(bfhi(b[0]), 1e-30f); v0[2] *= fmaxf(bflo(b[1]), 1e-30f); v0[3] *= fmaxf(bfhi(b[1]), 1e-30f);
                    v1[0] *= fmaxf(bflo(b[2]), 1e-30f); v1[1] *= fmaxf(bfhi(b[2]), 1e-30f); v1[2] *= fmaxf(bflo(b[3]), 1e-30f); v1[3] *= fmaxf(bfhi(b[3]), 1e-30f);
                    *(u32x4*)(Mo + off + bj * HALF) = pack8(v0, v1); }
                __builtin_amdgcn_sched_barrier(0); }
    }
};
template <bool WITH_H2> struct EpiResid {
    static constexpr bool PERM = false, AFTER_DRAIN = false, HAS_MID = false;
    const float* base; float* out; bf16_t* H2; const float* g; float* ssq;
    __device__ __forceinline__ void operator()(const f32x4 (&acc)[2][2][4][2], const Unit& u, int wr, int wc, int fr, int fq) const {
        const int row0 = u.pm * BM + wr * 64 + fr, col0 = u.pn * BM + wc * 32 + 4 * fq;
        f32x4 gv[2][2];
        if (WITH_H2) {
#pragma unroll
            for (int bj = 0; bj < 2; ++bj)
#pragma unroll
                for (int n = 0; n < 2; ++n) gv[bj][n] = *(const f32x4*)(g + col0 + bj * HALF + n * 16); }
#pragma unroll
        for (int ai = 0; ai < 2; ++ai)
#pragma unroll
            for (int m = 0; m < 4; ++m) { const int row = row0 + ai * HALF + m * 16; const size_t off = (size_t)row * 1024 + col0; float s = 0.f;
#pragma unroll
                for (int bj = 0; bj < 2; ++bj)
#pragma unroll
                    for (int n = 0; n < 2; ++n) { const f32x4 x1 = *(const f32x4*)(base + off + bj * HALF + n * 16) + acc[ai][bj][m][n];
                        *(f32x4*)(out + off + bj * HALF + n * 16) = x1; s += (x1[0] * x1[0] + x1[1] * x1[1]) + (x1[2] * x1[2] + x1[3] * x1[3]);
                        if (WITH_H2) { const f32x4 hv = x1 * gv[bj][n]; u32x2 w; w.x = cvt_pk_bf16(hv[0], hv[1]); w.y = cvt_pk_bf16(hv[2], hv[3]); *(u32x2*)(H2 + off + bj * HALF + n * 16) = w; } }
                s += __shfl_xor(s, 16); s += __shfl_xor(s, 32);
                if (fq == 0) ssq[(size_t)row * 16 + u.pn * 4 + wc] = s;
                __builtin_amdgcn_sched_barrier(0); }
    }
};
struct EpiFF1 {
    static constexpr bool PERM = true, AFTER_DRAIN = false, HAS_MID = false;
    const float* ssq; bf16_t* H; float eps;
    __device__ __forceinline__ void operator()(const f32x4 (&acc)[2][2][4][2], const Unit& u, int wr, int wc, int fr, int fq) const {
        const int row0 = u.pm * BM + wr * 64 + fr, col0 = u.pn * BM + wc * 32 + 8 * fq;
#pragma unroll
        for (int ai = 0; ai < 2; ++ai)
#pragma unroll
            for (int m = 0; m < 4; ++m) { const int row = row0 + ai * HALF + m * 16; const f32x4* sp = (const f32x4*)(ssq + (size_t)row * 16);
                const f32x4 p0 = sp[0], p1 = sp[1], p2 = sp[2], p3 = sp[3];
                const float s = (((p0[0] + p0[1]) + (p0[2] + p0[3])) + ((p1[0] + p1[1]) + (p1[2] + p1[3]))) + (((p2[0] + p2[1]) + (p2[2] + p2[3])) + ((p3[0] + p3[1]) + (p3[2] + p3[3])));
                const float rstd = 1.0f / sqrtf(s * (1.0f / 1024.0f) + eps);
#pragma unroll
                for (int bj = 0; bj < 2; ++bj) { f32x4 v0 = acc[ai][bj][m][0] * rstd, v1 = acc[ai][bj][m][1] * rstd;
#pragma unroll
                    for (int e = 0; e < 4; ++e) { v0[e] = fmaxf(v0[e], 0.f); v0[e] *= v0[e]; v1[e] = fmaxf(v1[e], 0.f); v1[e] *= v1[e]; }
                    *(u32x4*)(H + (size_t)row * 4096 + col0 + bj * HALF) = pack8(v0, v1); }
                __builtin_amdgcn_sched_barrier(0); }
    }
};
}
constexpr int NWAVES = 8;
constexpr int BATCH = 4, SEQ = 4096, D = 1024, T = BATCH * SEQ;
constexpr int LW = 512, RW = 512, FF = 4096, DIN = 5120;
constexpr float EPS = 1e-6f;
constexpr int C_Q = 1024, C_V = 2048;
constexpr size_t MiB = 1u << 20;
constexpr size_t WS_CTL = 0, CTL_ZERO_BYTES = 256 * 1024;
constexpr size_t WS_ROPE = 1 * MiB;
constexpr size_t WS_WIN = 2 * MiB;
constexpr size_t WS_WAB = 12 * MiB;
constexpr size_t WS_WO = 14 * MiB;
constexpr size_t WS_W1 = 16 * MiB;
constexpr size_t WS_W2 = 24 * MiB;
constexpr size_t WS_XN = 32 * MiB;
constexpr size_t WS_XA = 64 * MiB;
constexpr size_t WS_GA = 96 * MiB;
constexpr size_t WS_Q = 112 * MiB, WS_K = 128 * MiB, WS_V = 144 * MiB, WS_GR = 160 * MiB;
constexpr size_t WS_SA = 176 * MiB, WS_SB = 208 * MiB;
constexpr size_t WS_ST = 240 * MiB;
constexpr size_t WS_YAB = WS_XN, WS_M = WS_XA, WS_H2 = WS_XN, WS_HB = 96 * MiB;
constexpr size_t WS_SSQ1 = 224 * MiB, WS_SSQ2 = 225 * MiB;
constexpr size_t WS_END = 256 * MiB;
static_assert(WS_V - WS_GA == 48 * MiB && WS_GR - WS_GA == 64 * MiB && WS_SA - WS_GA == 80 * MiB && WS_SB - WS_GA == 112 * MiB, "EpiProj's destination arithmetic");
constexpr int CW_TMO = 0, CW_CODE = 1, CW_BAR = 4096;
constexpr int RING_OFF = 0, RING_BYTES = 131072;
constexpr int LDSCTL_OFF = RING_BYTES, MISC_OFF = LDSCTL_OFF + 320;
constexpr int LDS_BYTES = 147456;
#define GAS __attribute__((address_space(1)))
#define LAS __attribute__((address_space(3)))
typedef unsigned short bf16;
typedef unsigned v4u __attribute__((ext_vector_type(4)));
typedef float f32x4 __attribute__((ext_vector_type(4)));
typedef GAS unsigned gu32;
#define RLX_AGENT __ATOMIC_RELAXED, __HIP_MEMORY_SCOPE_AGENT
#define LDS_WAIT() asm volatile("s_waitcnt lgkmcnt(0)" ::: "memory")
#define VM_WAIT() asm volatile("s_waitcnt vmcnt(0)" ::: "memory")
__device__ __forceinline__ unsigned f2bf(float f) { unsigned u = __builtin_bit_cast(unsigned, f); return (u + 0x7fffu + ((u >> 16) & 1u)) >> 16; }
__device__ __forceinline__ unsigned pk2(float lo, float hi) { return f2bf(lo) | (f2bf(hi) << 16); }
__device__ __forceinline__ float bf2f(unsigned short h) { return __builtin_bit_cast(float, (unsigned)h << 16); }
#define XB_TMO      128
#define XB_XCNT(j)  (256  + 64 * (j))
#define XB_XSUB(j)  (1280 + 64 * (j))
#define XB_XGEN(j)  (2304 + 64 * (j))
#define XB_TOP      3328
#define XB_TOPGEN   3392
#define XCD_BAR_WORDS 3456
#define XB_SPIN_CAP (1u << 18)

__device__ __forceinline__ unsigned xb_ld(unsigned* p)              { return __hip_atomic_load(p, __ATOMIC_RELAXED, __HIP_MEMORY_SCOPE_AGENT); }
__device__ __forceinline__ unsigned xb_add(unsigned* p, unsigned v) { return __hip_atomic_fetch_add(p, v, __ATOMIC_RELAXED, __HIP_MEMORY_SCOPE_AGENT); }
__device__ __forceinline__ unsigned xb_xcc_id() { return (unsigned)__builtin_amdgcn_s_getreg((3 << 11) | 20) & 0xFu; }
#define XB_SPIN(cond, bar) do { unsigned _sp = 0; while (cond) { __builtin_amdgcn_s_sleep(1); \
    if ((++_sp & 255u) == 0u) { if (xb_ld(&(bar)[XB_TMO])) break; if (_sp > XB_SPIN_CAP) { atomicAdd(&(bar)[XB_TMO], 1u); break; } } } } while (0)

struct XcdBarrier {
    unsigned* bar; unsigned x;
    volatile LAS unsigned* st;
};

__device__ __forceinline__ XcdBarrier xcd_barrier_post(unsigned* bar, volatile LAS unsigned* st) {
    XcdBarrier b; b.bar = bar; b.x = xb_xcc_id(); b.st = st;
    if (threadIdx.x == 0) (void)xb_add(&bar[XB_XCNT(b.x)], 1u);
    return b;
}
__device__ __forceinline__ void xcd_barrier_complete(unsigned* bar, unsigned x, unsigned& nloc, unsigned& nx) {
    const unsigned G = gridDim.x * gridDim.y * gridDim.z;
    unsigned sum, cnt, mine, sp = 0u;
    for (;;) {
        sum = 0u; cnt = 0u; mine = 0u;
#pragma unroll
        for (unsigned j = 0; j < 16; ++j) { const unsigned c = xb_ld(&bar[XB_XCNT(j)]); sum += c; cnt += (c > 0u) ? 1u : 0u; mine = (j == x) ? c : mine; }
        if (sum == G) break;
        __builtin_amdgcn_s_sleep(1);
        if ((++sp & 255u) == 0u) { if (xb_ld(&bar[XB_TMO])) break; if (sp > XB_SPIN_CAP) { atomicAdd(&bar[XB_TMO], 1u); break; } }
    }
    nloc = mine > 0u ? mine : 1u; nx = cnt > 0u ? cnt : 1u;
}

__device__ __forceinline__ void xcd_barrier(const XcdBarrier& b) {
    asm volatile("s_waitcnt vmcnt(0)" ::: "memory");
    __syncthreads();
    if (threadIdx.x == 0) {
        unsigned* bar = b.bar;
        __builtin_amdgcn_s_waitcnt(0);
        unsigned nloc = b.st[0], nx = b.st[1];
        if (nloc == 0u) { xcd_barrier_complete(bar, b.x, nloc, nx); b.st[0] = nloc; b.st[1] = nx; }
        const unsigned old = xb_add(&bar[XB_XSUB(b.x)], 1u);
        const unsigned gen = old / nloc;
        if (old + 1u == (gen + 1u) * nloc) {
            __builtin_amdgcn_fence(__ATOMIC_RELEASE, "agent");
            asm volatile("s_waitcnt vmcnt(0)" ::: "memory");
            const unsigned og = xb_add(&bar[XB_TOP], 1u);
            const unsigned tg = og / nx;
            if (og + 1u == (tg + 1u) * nx) xb_add(&bar[XB_TOPGEN], 1u);
            else XB_SPIN(xb_ld(&bar[XB_TOPGEN]) == tg, bar);
            __builtin_amdgcn_fence(__ATOMIC_ACQUIRE, "agent");
            xb_add(&bar[XB_XGEN(b.x)], 1u);
            asm volatile("s_waitcnt vmcnt(0)" ::: "memory");
        } else {
            XB_SPIN(xb_ld(&bar[XB_XGEN(b.x)]) == gen, bar);
            __builtin_amdgcn_fence(__ATOMIC_ACQUIRE, "agent");
            asm volatile("s_waitcnt vmcnt(0)" ::: "memory");
        }
    }
    __syncthreads();
}
struct Args { const float* in[17]; float* out; unsigned char* ws; float inv[32]; float lg2g[8]; int ph_lo, ph_hi, li, pad; };
struct Frame {
    LAS unsigned char* lds; volatile LAS unsigned* MISC; gu32* ctl;
    int tid, lane, wave, vcu, G;
};
__device__ __forceinline__ int win_src_col(int nd) { if (nd >= C_Q && nd < C_V) { const int j = nd & 63; return (nd & ~63) + (j >> 1) + 32 * (j & 1); } return nd; }
template <bool PERM>
__device__ __forceinline__ void p0_transpose_item(const float* W, int N, bf16* WT, int ldk, int k_off, LAS float* scr, int item, int lane) {
    const int nblk = N / 32, kb = item / nblk, nb = item % nblk, k0 = 64 * kb, n0 = 32 * nb;
    const int sc = PERM ? win_src_col(n0 + (lane & 31)) : n0 + (lane & 31);
#pragma unroll 8
    for (int i = 0; i < 32; ++i) { const int kk = 2 * i + (lane >> 5); scr[kk * 33 + (lane & 31)] = W[(size_t)(k0 + kk) * N + sc]; }
    LDS_WAIT(); asm volatile("" ::: "memory");
    const int c = lane & 7;
#pragma unroll
    for (int j = 0; j < 4; ++j) { const int n = (lane >> 3) + 8 * j; const LAS float* s = scr + (8 * c) * 33 + n;
        v4u o; o.x = pk2(s[0 * 33], s[1 * 33]); o.y = pk2(s[2 * 33], s[3 * 33]); o.z = pk2(s[4 * 33], s[5 * 33]); o.w = pk2(s[6 * 33], s[7 * 33]);
        *(GAS v4u*)(WT + (size_t)(n0 + n) * ldk + k_off + k0 + 8 * c) = o; }
    LDS_WAIT(); asm volatile("" ::: "memory");
}
__device__ __forceinline__ float wave_sum(float v) {
#pragma unroll
    for (int o = 1; o < 64; o <<= 1) v += __shfl_xor(v, o);
    return v;
}
__device__ __forceinline__ void rms_row_to_bf16(int lane, const float* xrow, const float* g, bf16* orow) {
    const GAS f32x4* xr = (const GAS f32x4*)xrow + lane;
    f32x4 v[4]; float s = 0.f;
#pragma unroll
    for (int j = 0; j < 4; ++j) { v[j] = xr[64 * j]; s += (v[j].x * v[j].x + v[j].y * v[j].y) + (v[j].z * v[j].z + v[j].w * v[j].w); }
    const float rstd = 1.f / sqrtf(wave_sum(s) * (1.f / D) + EPS);
    GAS unsigned long long* o8 = (GAS unsigned long long*)orow + lane;
#pragma unroll
    for (int j = 0; j < 4; ++j) { const f32x4 gg = ((const GAS f32x4*)g)[lane + 64 * j]; const f32x4 o = v[j] * rstd * gg;
        o8[64 * j] = (unsigned long long)pk2(o.x, o.y) | ((unsigned long long)pk2(o.z, o.w) << 32); }
}
__device__ __forceinline__ void final_row(int lane, float* row, const float* ssq16, const float* g) {
    const GAS f32x4* sp = (const GAS f32x4*)ssq16;
    const f32x4 p0 = sp[0], p1 = sp[1], p2 = sp[2], p3 = sp[3];
    const float s = (((p0[0] + p0[1]) + (p0[2] + p0[3])) + ((p1[0] + p1[1]) + (p1[2] + p1[3]))) + (((p2[0] + p2[1]) + (p2[2] + p2[3])) + ((p3[0] + p3[1]) + (p3[2] + p3[3])));
    const float rstd = 1.0f / sqrtf(s * (1.0f / D) + EPS);
    GAS f32x4* xr = (GAS f32x4*)row + lane;
#pragma unroll
    for (int j = 0; j < 4; ++j) { const f32x4 gg = ((const GAS f32x4*)g)[lane + 64 * j]; xr[64 * j] = xr[64 * j] * rstd * gg; }
}

__global__ void __launch_bounds__(NWAVES * 64, 2) fwd(Args args) {
    extern __shared__ __attribute__((aligned(16))) unsigned char lds[];
    Frame F;
    F.lds = (LAS unsigned char*)lds;
    F.MISC = (volatile LAS unsigned*)(F.lds + MISC_OFF);
    F.tid = threadIdx.x; F.lane = F.tid & 63; F.wave = __builtin_amdgcn_readfirstlane(F.tid >> 6);
    F.G = gridDim.x; { const int bx = blockIdx.x; F.vcu = (F.G % 8 == 0) ? (bx % 8) * (F.G / 8) + bx / 8 : bx; }
    unsigned char* ws = args.ws;
    F.ctl = (gu32*)(ws + WS_CTL);
    const float* x = args.in[0]; float* out = args.out;
    bf16 *WinT = (bf16*)(ws + WS_WIN), *WabT = (bf16*)(ws + WS_WAB), *WoT = (bf16*)(ws + WS_WO), *W1T = (bf16*)(ws + WS_W1), *W2T = (bf16*)(ws + WS_W2);
    bf16 *XN = (bf16*)(ws + WS_XN), *GA = (bf16*)(ws + WS_GA), *Q = (bf16*)(ws + WS_Q), *Kb = (bf16*)(ws + WS_K), *V = (bf16*)(ws + WS_V), *GR = (bf16*)(ws + WS_GR);
    bf16 *SA = (bf16*)(ws + WS_SA), *SB = (bf16*)(ws + WS_SB), *YAB = (bf16*)(ws + WS_YAB), *Mb = (bf16*)(ws + WS_M), *H2 = (bf16*)(ws + WS_H2), *HB = (bf16*)(ws + WS_HB);
    float* XA = (float*)(ws + WS_XA); float* rope = (float*)(ws + WS_ROPE); float* SSQ1 = (float*)(ws + WS_SSQ1); float* SSQ2 = (float*)(ws + WS_SSQ2);
    for (int u = F.tid; u < (LDS_BYTES - LDSCTL_OFF) / 4; u += NWAVES * 64) ((LAS unsigned*)(F.lds + LDSCTL_OFF))[u] = 0u;
    __syncthreads();
    XcdBarrier bar = xcd_barrier_post((unsigned*)(F.ctl + CW_BAR) + args.li * XCD_BAR_WORDS, F.MISC + 8);
    const int lo = args.ph_lo, hi = args.ph_hi;
#define IN(k) (lo <= (k) && (k) < hi)
#define BOTH(k) (IN(k) && IN((k) + 1))
#define GRID_BAR() xcd_barrier(bar)
    const int gw = F.vcu * NWAVES + F.wave, NGW = F.G * NWAVES;

    if (IN(0)) {
        LAS float* scr = (LAS float*)(F.lds + RING_OFF + F.wave * 16384);
        constexpr int I_IN = (D / 64) * (DIN / 32), I_A = (LW / 64) * (D / 32), I_O = (D / 64) * (D / 32), I_1 = (D / 64) * (FF / 32), I_2 = (FF / 64) * (D / 32);
        constexpr int NITEMS = I_IN + 2 * I_A + I_O + I_1 + I_2;
        for (int it = gw; it < NITEMS; it += NGW) {
            int r = it;
            if (r < I_IN) { p0_transpose_item<true>(args.in[2], DIN, WinT, D, 0, scr, r, F.lane); continue; } r -= I_IN;
            if (r < I_A) { p0_transpose_item<false>(args.in[10], D, WabT, D, 0, scr, r, F.lane); continue; } r -= I_A;
            if (r < I_A) { p0_transpose_item<false>(args.in[11], D, WabT, D, LW, scr, r, F.lane); continue; } r -= I_A;
            if (r < I_O) { p0_transpose_item<false>(args.in[12], D, WoT, D, 0, scr, r, F.lane); continue; } r -= I_O;
            if (r < I_1) { p0_transpose_item<false>(args.in[14], FF, W1T, D, 0, scr, r, F.lane); continue; } r -= I_1;
            p0_transpose_item<false>(args.in[15], D, W2T, FF, 0, scr, r, F.lane);
        }
        for (int idx = F.vcu * (NWAVES * 64) + F.tid; idx < SEQ * 32; idx += F.G * NWAVES * 64) {
            const int pos = idx >> 5, i = idx & 31; float inv = 0.f;
#pragma unroll
            for (int k = 0; k < 32; ++k) inv = (i == k) ? args.inv[k] : inv;
            const float ang = (float)pos * inv;
            const double tr = (double)ang * 0.15915494309189535; const float rev = (float)(tr - floor(tr));
            rope[2 * idx] = __builtin_amdgcn_cosf(rev); rope[2 * idx + 1] = __builtin_amdgcn_sinf(rev);
        }
        for (int m = gw; m < T; m += NGW) rms_row_to_bf16(F.lane, x + (size_t)m * D, args.in[1], XN + (size_t)m * D);
        if (BOTH(0)) GRID_BAR();
    }
    if (IN(1)) {
        pg8::Gemm g{XN, WinT, T, DIN, D, D}; pg8::StaticOrder S; S.init(T, DIN, F.G, (int)blockIdx.x);
        pg8::EpiProj<false> E{XA, GA, Q, Kb, V, GR, SA, SB, rope, {args.lg2g[0], args.lg2g[1], args.lg2g[2], args.lg2g[3], args.lg2g[4], args.lg2g[5], args.lg2g[6], args.lg2g[7]}};
        pg8::gemm_phase<pg8::EpiProj<false>, pg8::StaticOrder, true, true>(F.lds + RING_OFF, g, S, E);
        if (BOTH(1)) GRID_BAR();
    }
    if (IN(2)) { if (BOTH(2)) GRID_BAR(); }
    if (IN(3)) { if (BOTH(3)) GRID_BAR(); }
    if (IN(4)) {
        pg8::Gemm g{YAB, WabT, T, D, LW, D}; pg8::PairOrder S; S.init(T, D, F.G, (int)blockIdx.x);
        pg8::EpiMerge E{SA, SB, Mb};
        pg8::gemm_phase<pg8::EpiMerge, pg8::PairOrder, false, true>(F.lds + RING_OFF, g, S, E);
        if (BOTH(4)) GRID_BAR();
    }
    if (IN(5)) {
        pg8::Gemm g{Mb, WoT, T, D, D, D}; pg8::StaticOrder S; S.init(T, D, F.G, (int)blockIdx.x);
        pg8::EpiResid<true> E{x, out, H2, args.in[13], SSQ1};
        pg8::gemm_phase<pg8::EpiResid<true>, pg8::StaticOrder, false, true>(F.lds + RING_OFF, g, S, E);
        if (BOTH(5)) GRID_BAR();
    }
    if (IN(6)) {
        pg8::Gemm g{H2, W1T, T, FF, D, D}; pg8::StaticOrder S; S.init(T, FF, F.G, (int)blockIdx.x);
        pg8::EpiFF1 E{SSQ1, HB, EPS};
        pg8::gemm_phase<pg8::EpiFF1, pg8::StaticOrder, true, true>(F.lds + RING_OFF, g, S, E);
        if (BOTH(6)) GRID_BAR();
    }
    if (IN(7)) {
        pg8::Gemm g{HB, W2T, T, D, FF, FF}; pg8::StaticOrder S; S.init(T, D, F.G, (int)blockIdx.x);
        pg8::EpiResid<false> E{out, out, nullptr, nullptr, SSQ2};
        pg8::gemm_phase<pg8::EpiResid<false>, pg8::StaticOrder, false, true>(F.lds + RING_OFF, g, S, E);
        if (BOTH(7)) GRID_BAR();
    }
    if (IN(8)) {
        for (int m = gw; m < T; m += NGW) final_row(F.lane, out + (size_t)m * D, SSQ2 + (size_t)m * 16, args.in[16]);
    }
#undef IN
#undef BOTH
#undef GRID_BAR
}
__global__ void __launch_bounds__(64) lru_naive(const float* __restrict__ XA, const bf16* __restrict__ GA, const float* __restrict__ conv_w, const float* __restrict__ conv_b,
                                                const float* __restrict__ wr, const float* __restrict__ br, const float* __restrict__ wi, const float* __restrict__ bi,
                                                const float* __restrict__ lam, bf16* __restrict__ YAB) {
    __shared__ float Wr[64][64], Wi[64][64], xs[64];
    const int b = blockIdx.x >> 3, h = blockIdx.x & 7, e = threadIdx.x, c = h * 64 + e;
    for (int d = 0; d < 64; ++d) { Wr[d][e] = wr[(size_t)(h * 64 + d) * 64 + e]; Wi[d][e] = wi[(size_t)(h * 64 + d) * 64 + e]; }
    const float w0 = conv_w[0 * LW + c], w1 = conv_w[1 * LW + c], w2 = conv_w[2 * LW + c], w3 = conv_w[3 * LW + c], cb = conv_b[c];
    const float bre = br[c], bie = bi[c];
    const float sp = log1pf(expf(-lam[c]));
    float x1 = 0.f, x2 = 0.f, x3 = 0.f, hs = 0.f;
    __syncthreads();
    for (int t = 0; t < SEQ; ++t) {
        const size_t row = (size_t)b * SEQ + t;
        const float x0 = XA[row * LW + c];
        const float xc = w3 * x0 + w2 * x1 + w1 * x2 + w0 * x3 + cb;
        x3 = x2; x2 = x1; x1 = x0;
        xs[e] = xc;
        __syncthreads();
        float pr = bre, pi = bie;
#pragma unroll 8
        for (int d = 0; d < 64; ++d) { const float xd = xs[d]; pr += xd * Wr[d][e]; pi += xd * Wi[d][e]; }
        __syncthreads();
        const float r = 1.f / (1.f + expf(-pr)), ig = 1.f / (1.f + expf(-pi));
        const float la = -8.f * r * sp, a = expf(la), mult = sqrtf(-expm1f(2.f * la));
        hs = a * hs + mult * (ig * xc);
        YAB[row * D + c] = (bf16)f2bf(bf2f(GA[row * LW + c]) * hs);
    }
}
__global__ void __launch_bounds__(256) ret_naive(const bf16* __restrict__ Q, const bf16* __restrict__ Kk, const bf16* __restrict__ V, const bf16* __restrict__ GR, bf16* __restrict__ YAB) {
    __shared__ float qs[64], ks[64], vs[64], red[4][64];
    const int b = blockIdx.x >> 3, h = blockIdx.x & 7, tid = threadIdx.x, e = tid & 63, dg = tid >> 6;
    const float gamma = 1.f - exp2f(-5.f - (float)h);
    float S[16];
#pragma unroll
    for (int j = 0; j < 16; ++j) S[j] = 0.f;
    for (int t = 0; t < SEQ; ++t) {
        const size_t row = (size_t)b * SEQ + t;
        if (dg == 0) qs[e] = bf2f(Q[row * RW + h * 64 + e]); else if (dg == 1) ks[e] = bf2f(Kk[row * RW + h * 64 + e]); else if (dg == 2) vs[e] = bf2f(V[row * RW + h * 64 + e]);
        __syncthreads();
        const float ve = vs[e]; float p = 0.f;
#pragma unroll
        for (int j = 0; j < 16; ++j) { S[j] = gamma * S[j] + ks[dg * 16 + j] * ve; p += qs[dg * 16 + j] * S[j]; }
        red[dg][e] = p;
        __syncthreads();
        if (dg == 0) {
            const float ret = (red[0][e] + red[1][e]) + (red[2][e] + red[3][e]);
            float s = ret * ret;
#pragma unroll
            for (int o = 1; o < 64; o <<= 1) s += __shfl_xor(s, o);
            const float y = ret * (1.f / sqrtf(s * (1.f / 64.f) + EPS)) * bf2f(GR[row * RW + h * 64 + e]);
            YAB[row * D + LW + h * 64 + e] = (bf16)f2bf(y);
        }
    }
}
extern "C" void kernel_launch(void* const* d_in, const int* in_sizes, int n_in, void* d_out, int out_size, void* d_ws, size_t ws_size, hipStream_t stream) {
    static int grid = 0;
    if (grid == 0) {
        if (n_in != 17 || in_sizes[0] != T * D || out_size != T * D || ws_size < WS_END) { fprintf(stderr, "kernel_launch: unexpected shapes (n_in %d, in0 %d, out %d, ws %zu); nothing launched\n", n_in, n_in > 0 ? in_sizes[0] : -1, out_size, ws_size); grid = -1; return; }
        int dev = 0, cus = 0, per_cu = 0;
        if (hipGetDevice(&dev) != hipSuccess || hipDeviceGetAttribute(&cus, hipDeviceAttributeMultiprocessorCount, dev) != hipSuccess) { fprintf(stderr, "kernel_launch: device query failed\n"); grid = -1; return; }
        if (hipFuncSetAttribute((const void*)fwd, hipFuncAttributeMaxDynamicSharedMemorySize, LDS_BYTES) != hipSuccess) { fprintf(stderr, "kernel_launch: hipFuncSetAttribute failed\n"); grid = -1; return; }
        if (hipOccupancyMaxActiveBlocksPerMultiprocessor(&per_cu, (const void*)fwd, NWAVES * 64, LDS_BYTES) != hipSuccess || per_cu < 1) { fprintf(stderr, "kernel_launch: occupancy query says %d blocks/CU\n", per_cu); }
        (void)hipGetLastError();
        grid = cus;
        if (grid != 256) fprintf(stderr, "kernel_launch: %d CUs (expected 256)\n", grid);
    }
    if (grid < 0) return;
    (void)hipMemsetAsync((char*)d_ws + WS_CTL, 0, CTL_ZERO_BYTES, stream);
    Args a{};
    for (int i = 0; i < 17; ++i) a.in[i] = (const float*)d_in[i];
    a.out = (float*)d_out; a.ws = (unsigned char*)d_ws;
    for (int i = 0; i < 32; ++i) a.inv[i] = (float)pow(10000.0, -(double)i / 32.0);
    for (int h = 0; h < 8; ++h) a.lg2g[h] = (float)log2(1.0 - exp2(-5.0 - (double)h));
    unsigned char* ws = (unsigned char*)d_ws;
    a.ph_lo = 0; a.ph_hi = 2; a.li = 0;
    hipLaunchKernelGGL(fwd, dim3(grid), dim3(NWAVES * 64), LDS_BYTES, stream, a);
    lru_naive<<<BATCH * 8, 64, 0, stream>>>((const float*)(ws + WS_XA), (const bf16*)(ws + WS_GA), a.in[3], a.in[4], a.in[5], a.in[6], a.in[7], a.in[8], a.in[9], (bf16*)(ws + WS_YAB));
    ret_naive<<<BATCH * 8, 256, 0, stream>>>((const bf16*)(ws + WS_Q), (const bf16*)(ws + WS_K), (const bf16*)(ws + WS_V), (const bf16*)(ws + WS_GR), (bf16*)(ws + WS_YAB));
    a.ph_lo = 4; a.ph_hi = 9; a.li = 1;
    hipLaunchKernelGGL(fwd, dim3(grid), dim3(NWAVES * 64), LDS_BYTES, stream, a);
}
```

```cpp
#include <hip/hip_runtime.h>
#include <cstdio>
#include <cstdint>
#include <cmath>
namespace pg8 {
#define PG8_LAS __attribute__((address_space(3)))
typedef unsigned short bf16_t;
typedef short bf16x8 __attribute__((ext_vector_type(8)));
typedef float f32x4 __attribute__((ext_vector_type(4)));
typedef unsigned u32x4 __attribute__((ext_vector_type(4)));
constexpr int BM = 256, BK = 64, HALF = 128, HTB = HALF * BK * 2  , STAGE_BYTES = 8 * HTB, NXCD = 8, WGM = 8;

__host__ __device__ __forceinline__ int lds_byte(int r, int c) { const int st = (r >> 4) * 2 + (c >> 5), rr = r & 15, cc = c & 31, ob = rr * 64 + cc * 2; return st * 1024 + (ob ^ (((ob >> 9) & 1) << 5)); }
__host__ __device__ __forceinline__ void stage_rc(int b, int& R, int& C) { const int st = b / 1024, sb = b % 1024, swz = sb ^ (((sb >> 9) & 1) << 5); R = (st >> 1) * 16 + swz / 64; C = (st & 1) * 32 + (swz % 64) / 2; }
__host__ __device__ __forceinline__ int perm32(int rho) { const int n = rho >> 4, i = rho & 15; return 8 * (i >> 2) + 4 * n + (i & 3); }

struct Unit { int pm, pn, kh; };
struct Gemm { const bf16_t* A; const bf16_t* Bt; int M, N, K, ld; };

struct StaticOrder {
    int nM, nN, nwg, G, c;
    __host__ __device__ void init(int M, int N, int G_, int c_) { nM = M / BM; nN = N / BM; nwg = nM * nN; G = G_; c = c_; }
    __host__ __device__ bool next(int i, Unit& u) const {
        const long L = (long)i * G + c; if (L >= nwg) return false;
        int wgid = (int)L; { const int q = nwg / NXCD, r = nwg % NXCD, xcd = wgid % NXCD, off = wgid / NXCD; wgid = (xcd < r ? xcd * (q + 1) : r * (q + 1) + (xcd - r) * q) + off; }
        const int nig = WGM * nN, gid = wgid / nig, fm = gid * WGM, gsz = (nM - fm) < WGM ? (nM - fm) : WGM;
        u.pm = fm + ((wgid % nig) % gsz); u.pn = (wgid % nig) / gsz; u.kh = 0; return true;
    }
    __device__ __forceinline__ void a_ready(const Unit&) const {}
    __device__ __forceinline__ void done(const Unit&) const {}
};
struct PairOrder : StaticOrder {
    __host__ __device__ bool next(int i, Unit& u) const { if (!StaticOrder::next(i >> 1, u)) return false; u.kh = i & 1; return true; }
};
struct OneUnitOrder : StaticOrder {
    int sel;
    __host__ __device__ bool next(int i, Unit& u) const { if (i != 0) return false; return StaticOrder::next(sel, u); }
};
typedef float f32x2_t __attribute__((ext_vector_type(2))); typedef __bf16 bf16x2_t __attribute__((ext_vector_type(2)));
__device__ __forceinline__ unsigned cvt_pk_bf16(float lo, float hi) { f32x2_t v = {lo, hi}; bf16x2_t b = __builtin_convertvector(v, bf16x2_t); return __builtin_bit_cast(unsigned, b); }
template <class Epi, class Sched, bool ALIGN_EPI = false, bool SP2 = false>
__device__ __forceinline__ void gemm_phase(PG8_LAS unsigned char* lds, const Gemm g, const Sched& S, const Epi& E) {
    const int tid = threadIdx.x, wid = __builtin_amdgcn_readfirstlane(tid >> 6), lane = tid & 63, wr = wid >> 2, wc = wid & 3, fr = lane & 15, fq = lane >> 4;
    const int K = g.K, LD = g.ld, nt = K / BK;
    unsigned voffA[2], voffB[2];
#pragma unroll
    for (int i = 0; i < 2; ++i) { int R, C; stage_rc(tid * 16 + i * 8192, R, C); const int Rb = Epi::PERM ? ((R & ~31) + perm32(R & 31)) : R;
        voffA[i] = (unsigned)(R * LD + C) * 2u; voffB[i] = (unsigned)(Rb * LD + C) * 2u; }
    const size_t kstep = (size_t)(BK * 2);
    const size_t hstep = (size_t)HALF * LD * 2;
    const size_t tstep = 2 * hstep;
    const unsigned ldsw = (unsigned)wid * 1024u;
    const int aoff = lds_byte(wr * 64 + fr, fq * 8), boff = lds_byte(wc * 32 + fr, fq * 8);
#define PG8_SA(b, h) (((b) * 2 + (h)) * HTB)
#define PG8_SB(b, h) ((4 + (b) * 2 + (h)) * HTB)
#define PG8_STAGE(bufoff, gbase, voff) do { _Pragma("unroll") for (int _i = 0; _i < 2; ++_i) \
        __builtin_amdgcn_global_load_lds((const unsigned*)((const char*)(gbase) + (voff)[_i]), (PG8_LAS unsigned*)(lds + (bufoff) + ldsw + _i * 8192), 16, 0, 0); } while (0)
#define PG8_LDA(dst, b, h) do { _Pragma("unroll") for (int m = 0; m < 4; ++m) _Pragma("unroll") for (int k = 0; k < 2; ++k) dst[m][k] = *(const PG8_LAS bf16x8*)(lds + PG8_SA(b, h) + aoff + m * 2048 + k * 1024); } while (0)
#define PG8_LDB(dst, b, h) do { _Pragma("unroll") for (int n = 0; n < 2; ++n) _Pragma("unroll") for (int k = 0; k < 2; ++k) dst[n][k] = *(const PG8_LAS bf16x8*)(lds + PG8_SB(b, h) + boff + n * 2048 + k * 1024); } while (0)
#define PG8_MMA(ai, bj, At, Bt) do { __builtin_amdgcn_s_setprio(1); _Pragma("unroll") for (int m = 0; m < 4; ++m) _Pragma("unroll") for (int n = 0; n < 2; ++n) _Pragma("unroll") for (int k = 0; k < 2; ++k) \
        acc[ai][bj][m][n] = __builtin_amdgcn_mfma_f32_16x16x32_bf16(Bt[n][k], At[m][k], acc[ai][bj][m][n], 0, 0, 0); __builtin_amdgcn_s_setprio(0); } while (0)
#define PG8_WAIT_V(n) asm volatile("s_waitcnt vmcnt(" #n ")" ::: "memory")
#define PG8_WAIT_L(n) asm volatile("s_waitcnt lgkmcnt(" #n ")" ::: "memory")
#define PG8_BAR __builtin_amdgcn_s_barrier()
#define PG8_SCHED __builtin_amdgcn_sched_barrier(0)
    Unit cur, nxt; int ui = 0;
    if (!S.next(0, cur)) return;
    f32x4 acc[2][2][4][2];
#pragma unroll
    for (int a = 0; a < 2; ++a)
#pragma unroll
        for (int b = 0; b < 2; ++b)
#pragma unroll
            for (int m = 0; m < 4; ++m)
#pragma unroll
                for (int n = 0; n < 2; ++n) acc[a][b][m][n] = (f32x4){0.f, 0.f, 0.f, 0.f};
    bf16x8 At[4][2], B0[2][2], B1[2][2];
    const size_t khstep = (size_t)K * 2;
    const char* cA = (const char*)g.A + (size_t)cur.pm * tstep + (size_t)cur.kh * khstep; const char* cB = (const char*)g.Bt + (size_t)cur.pn * tstep + (size_t)cur.kh * khstep;
    S.a_ready(cur);
    if constexpr (SP2) {
        PG8_STAGE(PG8_SB(0, 0), cB, voffB); PG8_STAGE(PG8_SB(0, 1), cB + hstep, voffB); PG8_STAGE(PG8_SA(0, 0), cA, voffA); PG8_STAGE(PG8_SA(0, 1), cA + hstep, voffA);
        if (wr == 1) PG8_BAR;
        PG8_WAIT_V(2); PG8_BAR;
        PG8_STAGE(PG8_SB(1, 0), cB + kstep, voffB); PG8_STAGE(PG8_SA(1, 0), cA + kstep, voffA); PG8_STAGE(PG8_SB(1, 1), cB + hstep + kstep, voffB);
        PG8_WAIT_V(6); PG8_BAR;
    } else {
        PG8_STAGE(PG8_SB(0, 0), cB, voffB); PG8_STAGE(PG8_SA(0, 0), cA, voffA); PG8_STAGE(PG8_SB(0, 1), cB + hstep, voffB); PG8_STAGE(PG8_SA(0, 1), cA + hstep, voffA);
        if (wr == 1) PG8_BAR;
        PG8_WAIT_V(4); PG8_BAR;
        PG8_STAGE(PG8_SB(1, 0), cB + kstep, voffB); PG8_STAGE(PG8_SA(1, 0), cA + kstep, voffA); PG8_STAGE(PG8_SB(1, 1), cB + hstep + kstep, voffB);
        PG8_WAIT_V(6); PG8_BAR;
    }
    for (;;) {
        const bool has_next = S.next(ui + 1, nxt);
        const char* nA = has_next ? (const char*)g.A + (size_t)nxt.pm * tstep + (size_t)nxt.kh * khstep : cA; const char* nB = has_next ? (const char*)g.Bt + (size_t)nxt.pn * tstep + (size_t)nxt.kh * khstep : cB;
        for (int t = 0; t < nt; t += 2) {
            const bool last = (t == nt - 2);
            const char* a1 = cA + (size_t)(t + 1) * kstep;
            const char* a2 = last ? nA : cA + (size_t)(t + 2) * kstep; const char* b2 = last ? nB : cB + (size_t)(t + 2) * kstep;
            const char* a3 = a2 + kstep; const char* b3 = b2 + kstep;
            if (last && has_next) S.a_ready(nxt);
            if constexpr (SP2) {
            PG8_LDB(B0, 0, 0); PG8_LDB(B1, 0, 1); PG8_SCHED; PG8_LDA(At, 0, 0); PG8_STAGE(PG8_SA(1, 1), a1 + hstep, voffA);
            PG8_WAIT_V(8); PG8_WAIT_L(0); PG8_BAR; PG8_MMA(0, 0, At, B0); PG8_MMA(0, 1, At, B1); PG8_BAR; PG8_SCHED;
            PG8_LDA(At, 0, 1); PG8_STAGE(PG8_SB(0, 0), b2, voffB); PG8_STAGE(PG8_SB(0, 1), b2 + hstep, voffB); PG8_STAGE(PG8_SA(0, 0), a2, voffA);
            PG8_WAIT_V(8); PG8_WAIT_L(0); PG8_BAR; PG8_MMA(1, 0, At, B0); PG8_MMA(1, 1, At, B1); PG8_BAR; PG8_SCHED;
            PG8_LDB(B0, 1, 0); PG8_LDB(B1, 1, 1); PG8_SCHED; PG8_LDA(At, 1, 0); PG8_STAGE(PG8_SA(0, 1), a2 + hstep, voffA);
            PG8_WAIT_V(8); PG8_WAIT_L(0); PG8_BAR; PG8_MMA(0, 0, At, B0); PG8_MMA(0, 1, At, B1); PG8_BAR; PG8_SCHED;
            PG8_LDA(At, 1, 1); PG8_STAGE(PG8_SB(1, 0), b3, voffB); PG8_STAGE(PG8_SB(1, 1), b3 + hstep, voffB); PG8_STAGE(PG8_SA(1, 0), a3, voffA);
            PG8_WAIT_V(8); PG8_WAIT_L(0); PG8_BAR; PG8_MMA(1, 0, At, B0); PG8_MMA(1, 1, At, B1); PG8_BAR; PG8_SCHED;
            } else {
            PG8_LDB(B0, 0, 0); PG8_SCHED; PG8_LDA(At, 0, 0); PG8_STAGE(PG8_SA(1, 1), a1 + hstep, voffA);
            PG8_WAIT_L(8); PG8_BAR; PG8_WAIT_L(0); PG8_MMA(0, 0, At, B0); PG8_BAR; PG8_SCHED;
            PG8_LDB(B1, 0, 1); PG8_STAGE(PG8_SB(0, 0), b2, voffB);
            PG8_BAR; PG8_WAIT_L(0); PG8_MMA(0, 1, At, B1); PG8_BAR;
            PG8_LDA(At, 0, 1); PG8_STAGE(PG8_SA(0, 0), a2, voffA);
            PG8_BAR; PG8_WAIT_L(0); PG8_MMA(1, 0, At, B0); PG8_BAR; PG8_SCHED;
            PG8_STAGE(PG8_SB(0, 1), b2 + hstep, voffB);
            PG8_WAIT_V(6); PG8_BAR; PG8_MMA(1, 1, At, B1); PG8_BAR;
            PG8_LDB(B0, 1, 0); PG8_SCHED; PG8_LDA(At, 1, 0); PG8_STAGE(PG8_SA(0, 1), a2 + hstep, voffA);
            PG8_WAIT_L(8); PG8_BAR; PG8_WAIT_L(0); PG8_MMA(0, 0, At, B0); PG8_BAR; PG8_SCHED;
            PG8_LDB(B1, 1, 1); PG8_STAGE(PG8_SB(1, 0), b3, voffB);
            PG8_BAR; PG8_WAIT_L(0); PG8_MMA(0, 1, At, B1); PG8_BAR;
            PG8_LDA(At, 1, 1); PG8_STAGE(PG8_SA(1, 0), a3, voffA);
            PG8_BAR; PG8_WAIT_L(0); PG8_MMA(1, 0, At, B0); PG8_BAR; PG8_SCHED;
            PG8_STAGE(PG8_SB(1, 1), b3 + hstep, voffB);
            PG8_WAIT_V(6); PG8_BAR; PG8_MMA(1, 1, At, B1); PG8_BAR;
            }
        }
        if constexpr (ALIGN_EPI) { if (wr == 0) PG8_BAR; }
        bool chain = false;
        if constexpr (Epi::HAS_MID) { if (cur.kh == 0) { E.mid(acc, cur, wr, wc, fr, fq); chain = true; } }
        if constexpr (!Epi::AFTER_DRAIN) { if (!chain) { E(acc, cur, wr, wc, fr, fq); S.done(cur); } }
        if (!has_next) break;
        if (!chain) {
#pragma unroll
        for (int a = 0; a < 2; ++a)
#pragma unroll
            for (int b = 0; b < 2; ++b)
#pragma unroll
                for (int m = 0; m < 4; ++m)
#pragma unroll
                    for (int n = 0; n < 2; ++n) acc[a][b][m][n] = (f32x4){0.f, 0.f, 0.f, 0.f};
        }
        cur = nxt; cA = nA; cB = nB; ++ui;
        if constexpr (ALIGN_EPI) { if (wr == 1) PG8_BAR; }
    }
    PG8_WAIT_V(0);
    if constexpr (!ALIGN_EPI) { if (wr == 0) PG8_BAR; }
    PG8_BAR;
    if constexpr (Epi::AFTER_DRAIN) { E.fused(acc, cur, wr, wc, fr, fq, lds, wid, lane); S.done(cur); }
#undef PG8_SA
#undef PG8_SB
#undef PG8_STAGE
#undef PG8_LDA
#undef PG8_LDB
#undef PG8_MMA
#undef PG8_WAIT_V
#undef PG8_WAIT_L
#undef PG8_BAR
#undef PG8_SCHED
}
}
namespace pg8 {
typedef unsigned u32x2 __attribute__((ext_vector_type(2)));
constexpr int SEQ_ = 4096;
__device__ __forceinline__ float fsig(float x) { return __builtin_amdgcn_rcpf(1.f + __expf(-x)); }
__device__ __forceinline__ float fgelu(float x) { return x * fsig(1.5957691216057308f * (x + 0.044715f * x * x * x)); }
__device__ __forceinline__ u32x4 pack8(const f32x4 a, const f32x4 b) { u32x4 w; w.x = cvt_pk_bf16(a[0], a[1]); w.y = cvt_pk_bf16(a[2], a[3]); w.z = cvt_pk_bf16(b[0], b[1]); w.w = cvt_pk_bf16(b[2], b[3]); return w; }
__device__ __forceinline__ float bflo(unsigned w) { return __builtin_bit_cast(float, w << 16); }
__device__ __forceinline__ float bfhi(unsigned w) { return __builtin_bit_cast(float, w & 0xffff0000u); }

struct EpiProj {
    static constexpr bool PERM = true, AFTER_DRAIN = false, HAS_MID = false;
    float* XA; bf16_t *GA, *Q, *K, *V, *GR, *SA, *SB; const float* rope; float lg2g[8]; int QSCALE;
    __device__ __forceinline__ void operator()(const f32x4 (&acc)[2][2][4][2], const Unit& u, int wr, int wc, int fr, int fq) const {
        const int pn = u.pn, row0 = u.pm * BM + wr * 64 + fr, ct = wc * 32 + 8 * fq;
        if (pn < 2) {
#pragma unroll
            for (int ai = 0; ai < 2; ++ai)
#pragma unroll
                for (int m = 0; m < 4; ++m) { float* rowp = XA + (size_t)(row0 + ai * HALF + m * 16) * 512 + pn * BM + ct;
#pragma unroll
                    for (int bj = 0; bj < 2; ++bj) { *(f32x4*)(rowp + bj * HALF) = acc[ai][bj][m][0]; *(f32x4*)(rowp + bj * HALF + 4) = acc[ai][bj][m][1]; } }
        } else if (pn >= 4 && pn < 8) {
            const bool isk = pn >= 6; bf16_t* dst = isk ? K : Q; const int cb = (pn & 1) * BM + ct, d0 = (ct & 63) >> 1;
            float lgh[2] = {0.f, 0.f};
            if (QSCALE) {
#pragma unroll
                for (int bj = 0; bj < 2; ++bj) { const int h = (pn & 1) * 4 + bj * 2 + (wc >> 1);
#pragma unroll
                    for (int k = 0; k < 8; ++k) lgh[bj] = (h == k) ? lg2g[k] : lgh[bj]; } }
#pragma unroll
            for (int ai = 0; ai < 2; ++ai)
#pragma unroll
                for (int m = 0; m < 4; ++m) { const int row = row0 + ai * HALF + m * 16; const float* rp = rope + ((size_t)(row & (SEQ_ - 1)) * 32 + d0) * 2;
                    const f32x4 cs0 = *(const f32x4*)rp, cs1 = *(const f32x4*)(rp + 4);
#pragma unroll
                    for (int bj = 0; bj < 2; ++bj) { const f32x4 a = acc[ai][bj][m][0], b = acc[ai][bj][m][1]; f32x4 o0, o1;
                        float sc = isk ? 0.125f : 1.f;
                        if (QSCALE) { const float e = (float)((row & 127) + 1) * lgh[bj]; sc *= __builtin_amdgcn_exp2f(isk ? -e : e); }
                        o0[0] = (a[0] * cs0[0] - a[1] * cs0[1]) * sc; o0[1] = (a[0] * cs0[1] + a[1] * cs0[0]) * sc; o0[2] = (a[2] * cs0[2] - a[3] * cs0[3]) * sc; o0[3] = (a[2] * cs0[3] + a[3] * cs0[2]) * sc;
                        o1[0] = (b[0] * cs1[0] - b[1] * cs1[1]) * sc; o1[1] = (b[0] * cs1[1] + b[1] * cs1[0]) * sc; o1[2] = (b[2] * cs1[2] - b[3] * cs1[3]) * sc; o1[3] = (b[2] * cs1[3] + b[3] * cs1[2]) * sc;
                        *(u32x4*)(dst + (size_t)row * 512 + cb + bj * HALF) = pack8(o0, o1); }
                    __builtin_amdgcn_sched_barrier(0); }
        } else {
            const bool isga = pn < 4, isv = pn >= 8 && pn < 10, issig = pn >= 12;
            bf16_t* dst = (bf16_t*)((unsigned char*)GA + ((size_t)(48 * (pn >= 8) + 16 * (pn >= 10) + 16 * (pn >= 12) + 32 * (pn >= 16)) << 20));
            const int ldc = issig ? 1024 : 512, col0 = (isga ? (pn - 2) : isv ? (pn - 8) : pn < 12 ? (pn - 10) : ((pn - 12) & 3)) * BM + ct;
            const float c3 = isga ? 0.044715f * 1.5957691216057308f : 0.f, c1 = isga ? 1.5957691216057308f : 1.f;
#pragma unroll
            for (int ai = 0; ai < 2; ++ai)
#pragma unroll
                for (int m = 0; m < 4; ++m) { bf16_t* rowp = dst + (size_t)(row0 + ai * HALF + m * 16) * ldc + col0;
#pragma unroll
                    for (int bj = 0; bj < 2; ++bj) { f32x4 v[2] = {acc[ai][bj][m][0], acc[ai][bj][m][1]};
#pragma unroll
                        for (int n = 0; n < 2; ++n)
#pragma unroll
                            for (int e = 0; e < 4; ++e) { const float x = v[n][e], z = x * (c1 + c3 * x * x), sg = fsig(z); v[n][e] = (issig ? 1.f : x) * (isv ? 1.f : sg); }
                        *(u32x4*)(rowp + bj * HALF) = pack8(v[0], v[1]); }
                    __builtin_amdgcn_sched_barrier(0); }
        }
    }
};
struct EpiMerge {
    static constexpr bool PERM = true, AFTER_DRAIN = false, HAS_MID = true;
    const bf16_t *SA, *SB; bf16_t* Mo;
    __device__ __forceinline__ void mid(f32x4 (&acc)[2][2][4][2], const Unit& u, int wr, int wc, int fr, int fq) const {
        const int row0 = u.pm * BM + wr * 64 + fr, col0 = u.pn * BM + wc * 32 + 8 * fq;
#pragma unroll
        for (int ai = 0; ai < 2; ++ai)
#pragma unroll
            for (int m = 0; m < 4; ++m) { const size_t off = (size_t)(row0 + ai * HALF + m * 16) * 1024 + col0;
#pragma unroll
                for (int bj = 0; bj < 2; ++bj) { const u32x4 a = *(const u32x4*)(SA + off + bj * HALF), b = *(const u32x4*)(SB + off + bj * HALF);
#pragma unroll
                    for (int e = 0; e < 4; ++e) { const float r0 = bflo(a[e]) * __builtin_amdgcn_rcpf(fmaxf(bflo(b[e]), 1e-30f)), r1 = bfhi(a[e]) * __builtin_amdgcn_rcpf(fmaxf(bfhi(b[e]), 1e-30f));
                        acc[ai][bj][m][e >> 1][2 * (e & 1)] *= r0; acc[ai][bj][m][e >> 1][2 * (e & 1) + 1] *= r1; } }
                __builtin_amdgcn_sched_barrier(0); }
    }
    __device__ __forceinline__ void operator()(const f32x4 (&acc)[2][2][4][2], const Unit& u, int wr, int wc, int fr, int fq) const {
        const int row0 = u.pm * BM + wr * 64 + fr, col0 = u.pn * BM + wc * 32 + 8 * fq;
#pragma unroll
        for (int ai = 0; ai < 2; ++ai)
#pragma unroll
            for (int m = 0; m < 4; ++m) { const size_t off = (size_t)(row0 + ai * HALF + m * 16) * 1024 + col0;
#pragma unroll
                for (int bj = 0; bj < 2; ++bj) { const u32x4 b = *(const u32x4*)(SB + off + bj * HALF); f32x4 v0 = acc[ai][bj][m][0], v1 = acc[ai][bj][m][1];
                    v0[0] *= fmaxf(bflo(b[0]), 1e-30f); v0[1] *= fmaxf(bfhi(b[0]), 1e-30f); v0[2] *= fmaxf(bflo(b[1]), 1e-30f); v0[3] *= fmaxf(bfhi(b[1]), 1e-30f);
                    v1[0] *= fmaxf(bflo(b[2]), 1e-30f); v1[1] *= fmaxf(bfhi(b[2]), 1e-30f); v1[2] *= fmaxf(bflo(b[3]), 1e-30f); v1[3] *= fmaxf(bfhi(b[3]), 1e-30f);
                    *(u32x4*)(Mo + off + bj * HALF) = pack8(v0, v1); }
                __builtin_amdgcn_sched_barrier(0); }
    }
};
template <bool WITH_H2> struct EpiResid {
    static constexpr bool PERM = false, AFTER_DRAIN = false, HAS_MID = false;
    const float* base; float* out; bf16_t* H2; const float* g; float* ssq;
    __device__ __forceinline__ void operator()(const f32x4 (&acc)[2][2][4][2], const Unit& u, int wr, int wc, int fr, int fq) const {
        const int row0 = u.pm * BM + wr * 64 + fr, col0 = u.pn * BM + wc * 32 + 4 * fq;
        f32x4 gv[2][2];
        if (WITH_H2) {
#pragma unroll
            for (int bj = 0; bj < 2; ++bj)
#pragma unroll
                for (int n = 0; n < 2; ++n) gv[bj][n] = *(const f32x4*)(g + col0 + bj * HALF + n * 16); }
#pragma unroll
        for (int ai = 0; ai < 2; ++ai)
#pragma unroll
            for (int m = 0; m < 4; ++m) { const int row = row0 + ai * HALF + m * 16; const size_t off = (size_t)row * 1024 + col0; float s = 0.f;
#pragma unroll
                for (int bj = 0; bj < 2; ++bj)
#pragma unroll
                    for (int n = 0; n < 2; ++n) { const f32x4 x1 = *(const f32x4*)(base + off + bj * HALF + n * 16) + acc[ai][bj][m][n];
                        *(f32x4*)(out + off + bj * HALF + n * 16) = x1; s += (x1[0] * x1[0] + x1[1] * x1[1]) + (x1[2] * x1[2] + x1[3] * x1[3]);
                        if (WITH_H2) { const f32x4 hv = x1 * gv[bj][n]; u32x2 w; w.x = cvt_pk_bf16(hv[0], hv[1]); w.y = cvt_pk_bf16(hv[2], hv[3]); *(u32x2*)(H2 + off + bj * HALF + n * 16) = w; } }
                s += __shfl_xor(s, 16); s += __shfl_xor(s, 32);
                if (fq == 0) ssq[(size_t)row * 16 + u.pn * 4 + wc] = s;
                __builtin_amdgcn_sched_barrier(0); }
    }
};
struct EpiFF1 {
    static constexpr bool PERM = true, AFTER_DRAIN = false, HAS_MID = false;
    const float* ssq; bf16_t* H; float eps;
    __device__ __forceinline__ void operator()(const f32x4 (&acc)[2][2][4][2], const Unit& u, int wr, int wc, int fr, int fq) const {
        const int row0 = u.pm * BM + wr * 64 + fr, col0 = u.pn * BM + wc * 32 + 8 * fq;
#pragma unroll
        for (int ai = 0; ai < 2; ++ai)
#pragma unroll
            for (int m = 0; m < 4; ++m) { const int row = row0 + ai * HALF + m * 16; const f32x4* sp = (const f32x4*)(ssq + (size_t)row * 16);
                const f32x4 p0 = sp[0], p1 = sp[1], p2 = sp[2], p3 = sp[3];
                const float s = (((p0[0] + p0[1]) + (p0[2] + p0[3])) + ((p1[0] + p1[1]) + (p1[2] + p1[3]))) + (((p2[0] + p2[1]) + (p2[2] + p2[3])) + ((p3[0] + p3[1]) + (p3[2] + p3[3])));
                const float rstd = 1.0f / sqrtf(s * (1.0f / 1024.0f) + eps);
#pragma unroll
                for (int bj = 0; bj < 2; ++bj) { f32x4 v0 = acc[ai][bj][m][0] * rstd, v1 = acc[ai][bj][m][1] * rstd;
#pragma unroll
                    for (int e = 0; e < 4; ++e) { v0[e] = fmaxf(v0[e], 0.f); v0[e] *= v0[e]; v1[e] = fmaxf(v1[e], 0.f); v1[e] *= v1[e]; }
                    *(u32x4*)(H + (size_t)row * 4096 + col0 + bj * HALF) = pack8(v0, v1); }
                __builtin_amdgcn_sched_barrier(0); }
    }
};
}
constexpr int NWAVES = 8;
constexpr int BATCH = 4, SEQ = 4096, D = 1024, T = BATCH * SEQ;
constexpr int LW = 512, RW = 512, FF = 4096, DIN = 5120;
constexpr float EPS = 1e-6f;
constexpr int C_Q = 1024, C_V = 2048;
constexpr size_t MiB = 1u << 20;
constexpr size_t WS_CTL = 0, CTL_ZERO_BYTES = 256 * 1024;
constexpr size_t WS_ROPE = 1 * MiB;
constexpr size_t WS_WIN = 2 * MiB;
constexpr size_t WS_WAB = 12 * MiB;
constexpr size_t WS_WO = 14 * MiB;
constexpr size_t WS_W1 = 16 * MiB;
constexpr size_t WS_W2 = 24 * MiB;
constexpr size_t WS_XN = 32 * MiB;
constexpr size_t WS_XA = 64 * MiB;
constexpr size_t WS_GA = 96 * MiB;
constexpr size_t WS_Q = 112 * MiB, WS_K = 128 * MiB, WS_V = 144 * MiB, WS_GR = 160 * MiB;
constexpr size_t WS_SA = 176 * MiB, WS_SB = 208 * MiB;
constexpr size_t WS_ST = 240 * MiB;
constexpr size_t WS_AGG = 244 * MiB;
constexpr size_t WS_WRI = 245 * MiB;
constexpr size_t WS_YAB = WS_XN, WS_M = WS_XA, WS_H2 = WS_XN, WS_HB = 96 * MiB;
constexpr size_t WS_SSQ1 = 224 * MiB, WS_SSQ2 = 225 * MiB;
constexpr size_t WS_END = 256 * MiB;
static_assert(WS_V - WS_GA == 48 * MiB && WS_GR - WS_GA == 64 * MiB && WS_SA - WS_GA == 80 * MiB && WS_SB - WS_GA == 112 * MiB, "EpiProj's destination arithmetic");
constexpr int CW_TMO = 0, CW_CODE = 1, CW_BAR = 4096;
constexpr int RING_OFF = 0, RING_BYTES = 131072;
constexpr int LDSCTL_OFF = RING_BYTES, MISC_OFF = LDSCTL_OFF + 320;
constexpr int LDS_BYTES = 155648;
#define GAS __attribute__((address_space(1)))
#define LAS __attribute__((address_space(3)))
typedef unsigned short bf16;
typedef unsigned v4u __attribute__((ext_vector_type(4)));
typedef float f32x4 __attribute__((ext_vector_type(4)));
typedef GAS unsigned gu32;
#define RLX_AGENT __ATOMIC_RELAXED, __HIP_MEMORY_SCOPE_AGENT
#define LDS_WAIT() asm volatile("s_waitcnt lgkmcnt(0)" ::: "memory")
#define VM_WAIT() asm volatile("s_waitcnt vmcnt(0)" ::: "memory")
__device__ __forceinline__ unsigned f2bf(float f) { unsigned u = __builtin_bit_cast(unsigned, f); return (u + 0x7fffu + ((u >> 16) & 1u)) >> 16; }
__device__ __forceinline__ unsigned pk2(float lo, float hi) { return f2bf(lo) | (f2bf(hi) << 16); }
__device__ __forceinline__ float bf2f(unsigned short h) { return __builtin_bit_cast(float, (unsigned)h << 16); }
#define XB_TMO      128
#define XB_XCNT(j)  (256  + 64 * (j))
#define XB_XSUB(j)  (1280 + 64 * (j))
#define XB_XGEN(j)  (2304 + 64 * (j))
#define XB_TOP      3328
#define XB_TOPGEN   3392
#define XCD_BAR_WORDS 3456
#define XB_SPIN_CAP (1u << 18)

__device__ __forceinline__ unsigned xb_ld(unsigned* p)              { return __hip_atomic_load(p, __ATOMIC_RELAXED, __HIP_MEMORY_SCOPE_AGENT); }
__device__ __forceinline__ unsigned xb_add(unsigned* p, unsigned v) { return __hip_atomic_fetch_add(p, v, __ATOMIC_RELAXED, __HIP_MEMORY_SCOPE_AGENT); }
__device__ __forceinline__ unsigned xb_xcc_id() { return (unsigned)__builtin_amdgcn_s_getreg((3 << 11) | 20) & 0xFu; }
#define XB_SPIN(cond, bar) do { unsigned _sp = 0; while (cond) { __builtin_amdgcn_s_sleep(1); \
    if ((++_sp & 255u) == 0u) { if (xb_ld(&(bar)[XB_TMO])) break; if (_sp > XB_SPIN_CAP) { atomicAdd(&(bar)[XB_TMO], 1u); break; } } } } while (0)

struct XcdBarrier {
    unsigned* bar; unsigned x;
    volatile LAS unsigned* st;
};

__device__ __forceinline__ XcdBarrier xcd_barrier_post(unsigned* bar, volatile LAS unsigned* st) {
    XcdBarrier b; b.bar = bar; b.x = xb_xcc_id(); b.st = st;
    if (threadIdx.x == 0) (void)xb_add(&bar[XB_XCNT(b.x)], 1u);
    return b;
}
__device__ __forceinline__ void xcd_barrier_complete(unsigned* bar, unsigned x, unsigned& nloc, unsigned& nx) {
    const unsigned G = gridDim.x * gridDim.y * gridDim.z;
    unsigned sum, cnt, mine, sp = 0u;
    for (;;) {
        sum = 0u; cnt = 0u; mine = 0u;
#pragma unroll
        for (unsigned j = 0; j < 16; ++j) { const unsigned c = xb_ld(&bar[XB_XCNT(j)]); sum += c; cnt += (c > 0u) ? 1u : 0u; mine = (j == x) ? c : mine; }
        if (sum == G) break;
        __builtin_amdgcn_s_sleep(1);
        if ((++sp & 255u) == 0u) { if (xb_ld(&bar[XB_TMO])) break; if (sp > XB_SPIN_CAP) { atomicAdd(&bar[XB_TMO], 1u); break; } }
    }
    nloc = mine > 0u ? mine : 1u; nx = cnt > 0u ? cnt : 1u;
}

__device__ __forceinline__ void xcd_barrier(const XcdBarrier& b) {
    asm volatile("s_waitcnt vmcnt(0)" ::: "memory");
    __syncthreads();
    if (threadIdx.x == 0) {
        unsigned* bar = b.bar;
        __builtin_amdgcn_s_waitcnt(0);
        unsigned nloc = b.st[0], nx = b.st[1];
        if (nloc == 0u) { xcd_barrier_complete(bar, b.x, nloc, nx); b.st[0] = nloc; b.st[1] = nx; }
        const unsigned old = xb_add(&bar[XB_XSUB(b.x)], 1u);
        const unsigned gen = old / nloc;
        if (old + 1u == (gen + 1u) * nloc) {
            __builtin_amdgcn_fence(__ATOMIC_RELEASE, "agent");
            asm volatile("s_waitcnt vmcnt(0)" ::: "memory");
            const unsigned og = xb_add(&bar[XB_TOP], 1u);
            const unsigned tg = og / nx;
            if (og + 1u == (tg + 1u) * nx) xb_add(&bar[XB_TOPGEN], 1u);
            else XB_SPIN(xb_ld(&bar[XB_TOPGEN]) == tg, bar);
            __builtin_amdgcn_fence(__ATOMIC_ACQUIRE, "agent");
            xb_add(&bar[XB_XGEN(b.x)], 1u);
            asm volatile("s_waitcnt vmcnt(0)" ::: "memory");
        } else {
            XB_SPIN(xb_ld(&bar[XB_XGEN(b.x)]) == gen, bar);
            __builtin_amdgcn_fence(__ATOMIC_ACQUIRE, "agent");
            asm volatile("s_waitcnt vmcnt(0)" ::: "memory");
        }
    }
    __syncthreads();
}
namespace mix {
typedef short bf16x8 __attribute__((ext_vector_type(8)));
typedef unsigned u32x2 __attribute__((ext_vector_type(2)));
#define MFMA16(a, b, c) __builtin_amdgcn_mfma_f32_16x16x32_bf16((a), (b), (c), 0, 0, 0)
constexpr int QS = 144, TS = 272;
constexpr int L_Q = 0, L_K = L_Q + 128 * QS, L_KT = L_K + 128 * QS, L_VT = L_KT + 64 * TS, L_P = L_VT + 64 * TS, L_ST = L_P + 128 * TS, L_END = L_ST + 64 * QS;
static_assert(L_END <= 131072, "retention LDS images fit the ring region");
constexpr int XS = 144;
constexpr int L_XC = 131072 + 1024, L_XC_WAVE = 16 * XS;
__device__ __forceinline__ float fsig(float x) { return __builtin_amdgcn_rcpf(1.f + __expf(-x)); }
__device__ __forceinline__ unsigned pkbf(float lo, float hi) { return pg8::cvt_pk_bf16(lo, hi); }

template <bool WANT_QK>
__device__ __forceinline__ void ret_stage(LAS unsigned char* lds, int tid, const bf16* Q, const bf16* K, const bf16* V, size_t r0, int h) {
#pragma unroll
    for (int i = 0; i < 2; ++i) { const int p = tid + 512 * i, t = p >> 3, ds = p & 7; const size_t src = (r0 + t) * 512 + h * 64 + ds * 8;
        const v4u kv = *(const GAS v4u*)(K + src), vv = *(const GAS v4u*)(V + src);
        if (WANT_QK) { const v4u qv = *(const GAS v4u*)(Q + src); *(LAS v4u*)(lds + L_Q + t * QS + ds * 16) = qv; *(LAS v4u*)(lds + L_K + t * QS + ds * 16) = kv; }
        const int tc = 2 * (t ^ (ds << 3));
#pragma unroll
        for (int j = 0; j < 8; ++j) { const unsigned short ke = (unsigned short)(kv[j >> 1] >> (16 * (j & 1))), ve = (unsigned short)(vv[j >> 1] >> (16 * (j & 1)));
            *(LAS unsigned short*)(lds + L_KT + (ds * 8 + j) * TS + tc) = ke; *(LAS unsigned short*)(lds + L_VT + (ds * 8 + j) * TS + tc) = ve; } }
}
__device__ __forceinline__ bf16x8 tfrag(LAS unsigned char* lds, int base, int r, int tb) { return *(const LAS bf16x8*)(lds + base + r * TS + 16 * (tb ^ ((r >> 3) & 7))); }
__device__ __forceinline__ void ret_kv(LAS unsigned char* lds, int w, int fr, int fq, f32x4 (&st)[2], float g128) {
    const int dt = w >> 1;
#pragma unroll
    for (int ks = 0; ks < 4; ++ks) { const bf16x8 af = tfrag(lds, L_KT, 16 * dt + fr, 4 * ks + fq);
#pragma unroll
        for (int i = 0; i < 2; ++i) { const bf16x8 bfr = tfrag(lds, L_VT, 16 * (2 * (w & 1) + i) + fr, 4 * ks + fq); st[i] = MFMA16(af, bfr, st[i]); } }
#pragma unroll
    for (int i = 0; i < 2; ++i) st[i] = st[i] * g128;
}
__device__ __forceinline__ void ret_group_agg(LAS unsigned char* lds, int tid, int unit, const bf16* K, const bf16* V, float* GST, const float (&lg2g)[8]) {
    const int w = __builtin_amdgcn_readfirstlane(tid >> 6), lane = tid & 63, fr = lane & 15, fq = lane >> 4;
    const int g = unit & 7, h = (unit >> 3) & 7, b = unit >> 6;
    float lg = 0.f;
#pragma unroll
    for (int k = 0; k < 8; ++k) lg = (h == k) ? lg2g[k] : lg;
    const float g128 = __builtin_amdgcn_exp2f(128.f * lg);
    f32x4 st[2] = {{0.f, 0.f, 0.f, 0.f}, {0.f, 0.f, 0.f, 0.f}};
    for (int n = 0; n < 4; ++n) {
        ret_stage<false>(lds, tid, nullptr, K, V, (size_t)b * 4096 + g * 512 + n * 128, h);
        __syncthreads();
        ret_kv(lds, w, fr, fq, st, g128);
        __syncthreads();
    }
#pragma unroll
    for (int i = 0; i < 2; ++i)
#pragma unroll
        for (int r = 0; r < 4; ++r) GST[(((size_t)unit * 8 + w) * 2 + i) * 256 + r * 64 + lane] = st[i][r];
}
__device__ __forceinline__ void ret_unit(LAS unsigned char* lds, int tid, int unit, const bf16* Q, const bf16* K, const bf16* V, const bf16* GR, const float* GST, bf16* YAB, const float (&lg2g)[8], float eps) {
    const int w = __builtin_amdgcn_readfirstlane(tid >> 6), lane = tid & 63, fr = lane & 15, fq = lane >> 4;
    const int g = unit & 7, h = (unit >> 3) & 7, b = unit >> 6;
    float lg = 0.f;
#pragma unroll
    for (int k = 0; k < 8; ++k) lg = (h == k) ? lg2g[k] : lg;
    const float g128 = __builtin_amdgcn_exp2f(128.f * lg), g512 = __builtin_amdgcn_exp2f(512.f * lg);
    f32x4 st[2] = {{0.f, 0.f, 0.f, 0.f}, {0.f, 0.f, 0.f, 0.f}};
    for (int j = 0; j < g; ++j) {
#pragma unroll
        for (int i = 0; i < 2; ++i)
#pragma unroll
            for (int r = 0; r < 4; ++r) st[i][r] = st[i][r] * g512 + GST[(((size_t)(unit - g + j) * 8 + w) * 2 + i) * 256 + r * 64 + lane];
    }
    const int dt = w >> 1;
    for (int n = 0; n < 4; ++n) {
        const size_t r0 = (size_t)b * 4096 + g * 512 + n * 128;
#pragma unroll
        for (int i = 0; i < 2; ++i) { u32x2 pk; pk.x = pkbf(st[i][0], st[i][1]); pk.y = pkbf(st[i][2], st[i][3]);
            *(LAS u32x2*)(lds + L_ST + (16 * (2 * (w & 1) + i) + fr) * QS + (16 * dt + 4 * fq) * 2) = pk; }
        ret_stage<true>(lds, tid, Q, K, V, r0, h);
        __syncthreads();
        bf16x8 qf[2];
#pragma unroll
        for (int ks = 0; ks < 2; ++ks) qf[ks] = *(const LAS bf16x8*)(lds + L_Q + (16 * w + fr) * QS + (8 * fq + 32 * ks) * 2);
#pragma unroll
        for (int jt = 0; jt < 8; ++jt) {
            f32x4 s = {0.f, 0.f, 0.f, 0.f};
#pragma unroll
            for (int ks = 0; ks < 2; ++ks) { const bf16x8 kf = *(const LAS bf16x8*)(lds + L_K + (16 * jt + fr) * QS + (8 * fq + 32 * ks) * 2); s = MFMA16(kf, qf[ks], s); }
            const int lim = (jt < w) ? 64 : ((jt == w) ? fr : -1);
#pragma unroll
            for (int r = 0; r < 4; ++r) s[r] = (4 * fq + r <= lim) ? s[r] : 0.f;
            u32x2 pk; pk.x = pkbf(s[0], s[1]); pk.y = pkbf(s[2], s[3]);
            *(LAS u32x2*)(lds + L_P + (16 * w + fr) * TS + (16 * jt + 4 * fq) * 2) = pk;
        }
        asm volatile("s_waitcnt lgkmcnt(0)" ::: "memory");
        f32x4 o[4];
#pragma unroll
        for (int et = 0; et < 4; ++et) o[et] = (f32x4){0.f, 0.f, 0.f, 0.f};
#pragma unroll
        for (int ks = 0; ks < 4; ++ks) { const bf16x8 pf = *(const LAS bf16x8*)(lds + L_P + (16 * w + fr) * TS + (32 * ks + 8 * fq) * 2);
#pragma unroll
            for (int et = 0; et < 4; ++et) o[et] = MFMA16(tfrag(lds, L_VT, 16 * et + fr, 4 * ks + fq), pf, o[et]); }
#pragma unroll
        for (int ks = 0; ks < 2; ++ks)
#pragma unroll
            for (int et = 0; et < 4; ++et) o[et] = MFMA16(*(const LAS bf16x8*)(lds + L_ST + (16 * et + fr) * QS + (8 * fq + 32 * ks) * 2), qf[ks], o[et]);
        ret_kv(lds, w, fr, fq, st, g128);
        float ss = 0.f;
#pragma unroll
        for (int et = 0; et < 4; ++et) ss += (o[et][0] * o[et][0] + o[et][1] * o[et][1]) + (o[et][2] * o[et][2] + o[et][3] * o[et][3]);
        ss += __shfl_xor(ss, 16); ss += __shfl_xor(ss, 32);
        const float rstd = 1.0f / sqrtf(ss * (1.0f / 64.0f) + eps);
        const size_t row = r0 + 16 * w + fr;
#pragma unroll
        for (int et = 0; et < 4; ++et) { const u32x2 gv = *(const GAS u32x2*)(GR + row * 512 + h * 64 + 16 * et + 4 * fq);
            u32x2 y; y.x = pkbf(o[et][0] * rstd * pg8::bflo(gv.x), o[et][1] * rstd * pg8::bfhi(gv.x)); y.y = pkbf(o[et][2] * rstd * pg8::bflo(gv.y), o[et][3] * rstd * pg8::bfhi(gv.y));
            *(GAS u32x2*)(YAB + row * 1024 + 512 + h * 64 + 16 * et + 4 * fq) = y; }
        __syncthreads();
    }
}

struct LruParams { const float* XA; const bf16* GA; const float* conv_w; const float* conv_b; const float* br; const float* bi; const float* lam; const bf16* WRI; float* AGG; bf16* YAB; };
template <bool FINAL>
__device__ __forceinline__ void lru_unit(LAS unsigned char* lds, int wave, int lane, int b, int ck, const LruParams& P) {
    const int hb = wave, fr = lane & 15, fq = lane >> 4;
    LAS unsigned char* xcl = lds + L_XC + wave * L_XC_WAVE;
    float cw[4][4], cb[4], brv[4], biv[4], sp8[4];
#pragma unroll
    for (int et = 0; et < 4; ++et) { const unsigned c = (unsigned)(hb * 64 + 16 * et + fr);
#pragma unroll
        for (int k = 0; k < 4; ++k) cw[k][et] = P.conv_w[k * 512 + c];
        cb[et] = P.conv_b[c]; brv[et] = P.br[c]; biv[et] = P.bi[c]; sp8[et] = -8.f * log1pf(__expf(-P.lam[c])); }
    bf16x8 wf[2][4][2];
#pragma unroll
    for (int gt = 0; gt < 2; ++gt)
#pragma unroll
        for (int et = 0; et < 4; ++et)
#pragma unroll
            for (int s = 0; s < 2; ++s) wf[gt][et][s] = *(const GAS bf16x8*)(P.WRI + (unsigned)(((hb * 2 + gt) * 64 + 16 * et + fr) * 64 + 8 * fq + 32 * s));
    float hc[4] = {0.f, 0.f, 0.f, 0.f}, at[4] = {1.f, 1.f, 1.f, 1.f};
    if (FINAL) {
        const int n4 = (ck + 3) >> 2, j0 = fq * n4, j1 = (j0 + n4 < ck) ? j0 + n4 : ck;
        float ap[4] = {1.f, 1.f, 1.f, 1.f}, bp[4] = {0.f, 0.f, 0.f, 0.f};
        for (int j = j0; j < j1; ++j) { const unsigned ao = (unsigned)(((b * 8 + hb) * 64 + j) * 128 + fr);
#pragma unroll
            for (int et = 0; et < 4; ++et) { const float a = P.AGG[ao + 16 * et], bb = P.AGG[ao + 64 + 16 * et]; bp[et] = a * bp[et] + bb; ap[et] = a * ap[et]; } }
#pragma unroll
        for (int q = 0; q < 4; ++q)
#pragma unroll
            for (int et = 0; et < 4; ++et) { const float a = __shfl(ap[et], fr + 16 * q), bb = __shfl(bp[et], fr + 16 * q); hc[et] = a * hc[et] + bb; }
    }
    const int t00 = b * 4096 + ck * 64;
    for (int tile = 0; tile < 4; ++tile) {
        const int tb = t00 + tile * 16 + 4 * fq;
        const int sb = (tb & 4095);
        float xr[7][4];
#pragma unroll
        for (int k = 0; k < 7; ++k) { const bool ok = (sb + k - 3) >= 0; const unsigned ro = (unsigned)((ok ? tb + k - 3 : tb) * 512 + hb * 64 + fr);
#pragma unroll
            for (int et = 0; et < 4; ++et) { const float v = P.XA[ro + 16 * et]; xr[k][et] = ok ? v : 0.f; } }
        float xc[4][4];
#pragma unroll
        for (int r = 0; r < 4; ++r)
#pragma unroll
            for (int et = 0; et < 4; ++et) xc[r][et] = cw[3][et] * xr[r + 3][et] + cw[2][et] * xr[r + 2][et] + cw[1][et] * xr[r + 1][et] + cw[0][et] * xr[r][et] + cb[et];
#pragma unroll
        for (int r = 0; r < 4; ++r)
#pragma unroll
            for (int et = 0; et < 4; ++et) *(LAS unsigned short*)(xcl + (4 * fq + r) * XS + (16 * et + fr) * 2) = (unsigned short)f2bf(xc[r][et]);
        asm volatile("s_waitcnt lgkmcnt(0)" ::: "memory");
        bf16x8 af[2];
#pragma unroll
        for (int s = 0; s < 2; ++s) af[s] = *(const LAS bf16x8*)(xcl + fr * XS + (8 * fq + 32 * s) * 2);
        asm volatile("s_waitcnt lgkmcnt(0)" ::: "memory");
        float aa[4][4], uu[4][4];
#pragma unroll
        for (int et = 0; et < 4; ++et) { f32x4 gr = {0.f, 0.f, 0.f, 0.f}, gi = {0.f, 0.f, 0.f, 0.f};
#pragma unroll
            for (int s = 0; s < 2; ++s) { gr = MFMA16(af[s], wf[0][et][s], gr); gi = MFMA16(af[s], wf[1][et][s], gi); }
#pragma unroll
            for (int r = 0; r < 4; ++r) { const float rg = fsig(gr[r] + brv[et]), ig = fsig(gi[r] + biv[et]);
                const float la = sp8[et] * rg, a = __expf(la), x2 = 2.f * la;
                const float om = (x2 > -0.1f) ? -x2 * (1.f + x2 * (0.5f + x2 * (0.16666667f + x2 * 0.041666668f))) : 1.f - a * a;
                aa[r][et] = a; uu[r][et] = __builtin_amdgcn_sqrtf(om) * (ig * xc[r][et]); } }
        float hl[4][4], pl[4][4];
#pragma unroll
        for (int et = 0; et < 4; ++et) { hl[0][et] = uu[0][et]; pl[0][et] = aa[0][et];
#pragma unroll
            for (int r = 1; r < 4; ++r) { hl[r][et] = aa[r][et] * hl[r - 1][et] + uu[r][et]; pl[r][et] = aa[r][et] * pl[r - 1][et]; } }
        float hin[4];
#pragma unroll
        for (int et = 0; et < 4; ++et) { float H = hc[et], mine = hc[et], A = 1.f;
#pragma unroll
            for (int q = 0; q < 4; ++q) { const float a = __shfl(pl[3][et], fr + 16 * q), bb = __shfl(hl[3][et], fr + 16 * q); mine = (q == fq) ? H : mine; H = a * H + bb; A *= a; }
            hin[et] = mine; hc[et] = H; at[et] *= A; }
        if (FINAL) {
#pragma unroll
            for (int r = 0; r < 4; ++r) { const unsigned row = (unsigned)(tb + r), c0 = (unsigned)(hb * 64 + fr);
#pragma unroll
                for (int et = 0; et < 4; ++et) { const float hv = hl[r][et] + pl[r][et] * hin[et];
                    P.YAB[row * 1024u + c0 + 16 * et] = (bf16)f2bf(bf2f(P.GA[row * 512u + c0 + 16 * et]) * hv); } }
        }
    }
    if (!FINAL) { if (fq == 0) { const unsigned ao = (unsigned)(((b * 8 + hb) * 64 + ck) * 128 + fr);
#pragma unroll
        for (int et = 0; et < 4; ++et) { P.AGG[ao + 16 * et] = at[et]; P.AGG[ao + 64 + 16 * et] = hc[et]; } } }
}
}
struct Args { const float* in[17]; float* out; unsigned char* ws; float inv[32]; float lg2g[8]; int ph_lo, ph_hi, li, pad; };
struct Frame {
    LAS unsigned char* lds; volatile LAS unsigned* MISC; gu32* ctl;
    int tid, lane, wave, vcu, G;
};
__device__ __forceinline__ int win_src_col(int nd) { if (nd >= C_Q && nd < C_V) { const int j = nd & 63; return (nd & ~63) + (j >> 1) + 32 * (j & 1); } return nd; }
template <bool PERM>
__device__ __forceinline__ void p0_transpose_item(const float* W, int N, bf16* WT, int ldk, int k_off, LAS float* scr, int item, int lane) {
    const int nblk = N / 32, kb = item / nblk, nb = item % nblk, k0 = 64 * kb, n0 = 32 * nb;
    const int sc = PERM ? win_src_col(n0 + (lane & 31)) : n0 + (lane & 31);
#pragma unroll 8
    for (int i = 0; i < 32; ++i) { const int kk = 2 * i + (lane >> 5); scr[kk * 33 + (lane & 31)] = W[(size_t)(k0 + kk) * N + sc]; }
    LDS_WAIT(); asm volatile("" ::: "memory");
    const int c = lane & 7;
#pragma unroll
    for (int j = 0; j < 4; ++j) { const int n = (lane >> 3) + 8 * j; const LAS float* s = scr + (8 * c) * 33 + n;
        v4u o; o.x = pk2(s[0 * 33], s[1 * 33]); o.y = pk2(s[2 * 33], s[3 * 33]); o.z = pk2(s[4 * 33], s[5 * 33]); o.w = pk2(s[6 * 33], s[7 * 33]);
        *(GAS v4u*)(WT + (size_t)(n0 + n) * ldk + k_off + k0 + 8 * c) = o; }
    LDS_WAIT(); asm volatile("" ::: "memory");
}
__device__ __forceinline__ float wave_sum(float v) {
#pragma unroll
    for (int o = 1; o < 64; o <<= 1) v += __shfl_xor(v, o);
    return v;
}
__device__ __forceinline__ void rms_row_to_bf16(int lane, const float* xrow, const float* g, bf16* orow) {
    const GAS f32x4* xr = (const GAS f32x4*)xrow + lane;
    f32x4 v[4]; float s = 0.f;
#pragma unroll
    for (int j = 0; j < 4; ++j) { v[j] = xr[64 * j]; s += (v[j].x * v[j].x + v[j].y * v[j].y) + (v[j].z * v[j].z + v[j].w * v[j].w); }
    const float rstd = 1.f / sqrtf(wave_sum(s) * (1.f / D) + EPS);
    GAS unsigned long long* o8 = (GAS unsigned long long*)orow + lane;
#pragma unroll
    for (int j = 0; j < 4; ++j) { const f32x4 gg = ((const GAS f32x4*)g)[lane + 64 * j]; const f32x4 o = v[j] * rstd * gg;
        o8[64 * j] = (unsigned long long)pk2(o.x, o.y) | ((unsigned long long)pk2(o.z, o.w) << 32); }
}
__device__ __forceinline__ void final_row(int lane, float* row, const float* ssq16, const float* g) {
    const GAS f32x4* sp = (const GAS f32x4*)ssq16;
    const f32x4 p0 = sp[0], p1 = sp[1], p2 = sp[2], p3 = sp[3];
    const float s = (((p0[0] + p0[1]) + (p0[2] + p0[3])) + ((p1[0] + p1[1]) + (p1[2] + p1[3]))) + (((p2[0] + p2[1]) + (p2[2] + p2[3])) + ((p3[0] + p3[1]) + (p3[2] + p3[3])));
    const float rstd = 1.0f / sqrtf(s * (1.0f / D) + EPS);
    GAS f32x4* xr = (GAS f32x4*)row + lane;
#pragma unroll
    for (int j = 0; j < 4; ++j) { const f32x4 gg = ((const GAS f32x4*)g)[lane + 64 * j]; xr[64 * j] = xr[64 * j] * rstd * gg; }
}

__global__ void __launch_bounds__(NWAVES * 64, 2) fwd(Args args) {
    extern __shared__ __attribute__((aligned(16))) unsigned char lds[];
    Frame F;
    F.lds = (LAS unsigned char*)lds;
    F.MISC = (volatile LAS unsigned*)(F.lds + MISC_OFF);
    F.tid = threadIdx.x; F.lane = F.tid & 63; F.wave = __builtin_amdgcn_readfirstlane(F.tid >> 6);
    F.G = gridDim.x; { const int bx = blockIdx.x; F.vcu = (F.G % 8 == 0) ? (bx % 8) * (F.G / 8) + bx / 8 : bx; }
    unsigned char* ws = args.ws;
    F.ctl = (gu32*)(ws + WS_CTL);
    const float* x = args.in[0]; float* out = args.out;
    bf16 *WinT = (bf16*)(ws + WS_WIN), *WabT = (bf16*)(ws + WS_WAB), *WoT = (bf16*)(ws + WS_WO), *W1T = (bf16*)(ws + WS_W1), *W2T = (bf16*)(ws + WS_W2);
    bf16 *XN = (bf16*)(ws + WS_XN), *GA = (bf16*)(ws + WS_GA), *Q = (bf16*)(ws + WS_Q), *Kb = (bf16*)(ws + WS_K), *V = (bf16*)(ws + WS_V), *GR = (bf16*)(ws + WS_GR);
    bf16 *SA = (bf16*)(ws + WS_SA), *SB = (bf16*)(ws + WS_SB), *YAB = (bf16*)(ws + WS_YAB), *Mb = (bf16*)(ws + WS_M), *H2 = (bf16*)(ws + WS_H2), *HB = (bf16*)(ws + WS_HB);
    bf16* WRI = (bf16*)(ws + WS_WRI); float* GST = (float*)(ws + WS_ST); float* AGG = (float*)(ws + WS_AGG);
    float* XA = (float*)(ws + WS_XA); float* rope = (float*)(ws + WS_ROPE); float* SSQ1 = (float*)(ws + WS_SSQ1); float* SSQ2 = (float*)(ws + WS_SSQ2);
    for (int u = F.tid; u < (LDS_BYTES - LDSCTL_OFF) / 4; u += NWAVES * 64) ((LAS unsigned*)(F.lds + LDSCTL_OFF))[u] = 0u;
    __syncthreads();
    XcdBarrier bar = xcd_barrier_post((unsigned*)(F.ctl + CW_BAR) + args.li * XCD_BAR_WORDS, F.MISC + 8);
    const int lo = args.ph_lo, hi = args.ph_hi;
#define IN(k) (lo <= (k) && (k) < hi)
#define BOTH(k) (IN(k) && IN((k) + 1))
#define GRID_BAR() xcd_barrier(bar)
    const int gw = F.vcu * NWAVES + F.wave, NGW = F.G * NWAVES;

    if (IN(0)) {
        LAS float* scr = (LAS float*)(F.lds + RING_OFF + F.wave * 16384);
        constexpr int I_IN = (D / 64) * (DIN / 32), I_A = (LW / 64) * (D / 32), I_O = (D / 64) * (D / 32), I_1 = (D / 64) * (FF / 32), I_2 = (FF / 64) * (D / 32);
        constexpr int NITEMS = I_IN + 2 * I_A + I_O + I_1 + I_2;
        for (int it = gw; it < NITEMS; it += NGW) {
            int r = it;
            if (r < I_IN) { p0_transpose_item<true>(args.in[2], DIN, WinT, D, 0, scr, r, F.lane); continue; } r -= I_IN;
            if (r < I_A) { p0_transpose_item<false>(args.in[10], D, WabT, D, 0, scr, r, F.lane); continue; } r -= I_A;
            if (r < I_A) { p0_transpose_item<false>(args.in[11], D, WabT, D, LW, scr, r, F.lane); continue; } r -= I_A;
            if (r < I_O) { p0_transpose_item<false>(args.in[12], D, WoT, D, 0, scr, r, F.lane); continue; } r -= I_O;
            if (r < I_1) { p0_transpose_item<false>(args.in[14], FF, W1T, D, 0, scr, r, F.lane); continue; } r -= I_1;
            p0_transpose_item<false>(args.in[15], D, W2T, FF, 0, scr, r, F.lane);
        }
        for (int idx = F.vcu * (NWAVES * 64) + F.tid; idx < SEQ * 32; idx += F.G * NWAVES * 64) {
            const int pos = idx >> 5, i = idx & 31; float inv = 0.f;
#pragma unroll
            for (int k = 0; k < 32; ++k) inv = (i == k) ? args.inv[k] : inv;
            const float ang = (float)pos * inv;
            const double tr = (double)ang * 0.15915494309189535; const float rev = (float)(tr - floor(tr));
            rope[2 * idx] = __builtin_amdgcn_cosf(rev); rope[2 * idx + 1] = __builtin_amdgcn_sinf(rev);
        }
        for (int m = gw; m < T; m += NGW) rms_row_to_bf16(F.lane, x + (size_t)m * D, args.in[1], XN + (size_t)m * D);
        for (int idx = F.vcu * (NWAVES * 64) + F.tid; idx < 8 * 2 * 64 * 64; idx += F.G * NWAVES * 64) {
            const int hb = idx >> 13, gt = (idx >> 12) & 1, e = (idx >> 6) & 63, d = idx & 63;
            WRI[idx] = (bf16)f2bf((gt ? args.in[7] : args.in[5])[(size_t)(hb * 64 + d) * 64 + e]);
        }
        if (BOTH(0)) GRID_BAR();
    }
    if (IN(1)) {
        pg8::Gemm g{XN, WinT, T, DIN, D, D}; pg8::StaticOrder S; S.init(T, DIN, F.G, (int)blockIdx.x);
        pg8::EpiProj E{XA, GA, Q, Kb, V, GR, SA, SB, rope, {args.lg2g[0], args.lg2g[1], args.lg2g[2], args.lg2g[3], args.lg2g[4], args.lg2g[5], args.lg2g[6], args.lg2g[7]}, (args.pad >> 2) & 1};
        pg8::gemm_phase<pg8::EpiProj, pg8::StaticOrder, true, true>(F.lds + RING_OFF, g, S, E);
        if (BOTH(1)) GRID_BAR();
    }
    const float lgv[8] = {args.lg2g[0], args.lg2g[1], args.lg2g[2], args.lg2g[3], args.lg2g[4], args.lg2g[5], args.lg2g[6], args.lg2g[7]};
    const mix::LruParams LP{XA, GA, args.in[3], args.in[4], args.in[6], args.in[8], args.in[9], WRI, AGG, YAB};
    if (IN(2)) {
        { const int unit = F.vcu;
            if (args.pad & 1) mix::ret_group_agg(F.lds, F.tid, unit, Kb, V, GST, lgv);
            if (args.pad & 2) mix::lru_unit<false>(F.lds, F.wave, F.lane, unit >> 6, unit & 63, LP);
        }
        if (BOTH(2)) GRID_BAR();
    }
    if (IN(3)) {
        { const int unit = F.vcu;
            if (args.pad & 2) mix::lru_unit<true>(F.lds, F.wave, F.lane, unit >> 6, unit & 63, LP);
            if (args.pad & 1) mix::ret_unit(F.lds, F.tid, unit, Q, Kb, V, GR, GST, YAB, lgv, EPS);
        }
        if (BOTH(3)) GRID_BAR();
    }
    if (IN(4)) {
        pg8::Gemm g{YAB, WabT, T, D, LW, D}; pg8::PairOrder S; S.init(T, D, F.G, (int)blockIdx.x);
        pg8::EpiMerge E{SA, SB, Mb};
        pg8::gemm_phase<pg8::EpiMerge, pg8::PairOrder, false, true>(F.lds + RING_OFF, g, S, E);
        if (BOTH(4)) GRID_BAR();
    }
    if (IN(5)) {
        pg8::Gemm g{Mb, WoT, T, D, D, D}; pg8::StaticOrder S; S.init(T, D, F.G, (int)blockIdx.x);
        pg8::EpiResid<true> E{x, out, H2, args.in[13], SSQ1};
        pg8::gemm_phase<pg8::EpiResid<true>, pg8::StaticOrder, false, true>(F.lds + RING_OFF, g, S, E);
        if (BOTH(5)) GRID_BAR();
    }
    if (IN(6)) {
        pg8::Gemm g{H2, W1T, T, FF, D, D}; pg8::StaticOrder S; S.init(T, FF, F.G, (int)blockIdx.x);
        pg8::EpiFF1 E{SSQ1, HB, EPS};
        pg8::gemm_phase<pg8::EpiFF1, pg8::StaticOrder, true, true>(F.lds + RING_OFF, g, S, E);
        if (BOTH(6)) GRID_BAR();
    }
    if (IN(7)) {
        pg8::Gemm g{HB, W2T, T, D, FF, FF}; pg8::StaticOrder S; S.init(T, D, F.G, (int)blockIdx.x);
        pg8::EpiResid<false> E{out, out, nullptr, nullptr, SSQ2};
        pg8::gemm_phase<pg8::EpiResid<false>, pg8::StaticOrder, false, true>(F.lds + RING_OFF, g, S, E);
        if (BOTH(7)) GRID_BAR();
    }
    if (IN(8)) {
        for (int m = gw; m < T; m += NGW) final_row(F.lane, out + (size_t)m * D, SSQ2 + (size_t)m * 16, args.in[16]);
    }
#undef IN
#undef BOTH
#undef GRID_BAR
}
extern "C" void kernel_launch(void* const* d_in, const int* in_sizes, int n_in, void* d_out, int out_size, void* d_ws, size_t ws_size, hipStream_t stream) {
    static int grid = 0;
    if (grid == 0) {
        if (n_in != 17 || in_sizes[0] != T * D || out_size != T * D || ws_size < WS_END) { fprintf(stderr, "kernel_launch: unexpected shapes (n_in %d, in0 %d, out %d, ws %zu); nothing launched\n", n_in, n_in > 0 ? in_sizes[0] : -1, out_size, ws_size); grid = -1; return; }
        int dev = 0, cus = 0, per_cu = 0;
        if (hipGetDevice(&dev) != hipSuccess || hipDeviceGetAttribute(&cus, hipDeviceAttributeMultiprocessorCount, dev) != hipSuccess) { fprintf(stderr, "kernel_launch: device query failed\n"); grid = -1; return; }
        if (hipFuncSetAttribute((const void*)fwd, hipFuncAttributeMaxDynamicSharedMemorySize, LDS_BYTES) != hipSuccess) { fprintf(stderr, "kernel_launch: hipFuncSetAttribute failed\n"); grid = -1; return; }
        if (hipOccupancyMaxActiveBlocksPerMultiprocessor(&per_cu, (const void*)fwd, NWAVES * 64, LDS_BYTES) != hipSuccess || per_cu < 1) { fprintf(stderr, "kernel_launch: occupancy query says %d blocks/CU\n", per_cu); }
        (void)hipGetLastError();
        grid = cus;
        if (grid != 256) { fprintf(stderr, "kernel_launch: %d CUs; this kernel maps one mixer unit per workgroup and needs exactly 256; nothing launched\n", grid); grid = -1; return; }
    }
    if (grid < 0) return;
    (void)hipMemsetAsync((char*)d_ws + WS_CTL, 0, CTL_ZERO_BYTES, stream);
    Args a{};
    for (int i = 0; i < 17; ++i) a.in[i] = (const float*)d_in[i];
    a.out = (float*)d_out; a.ws = (unsigned char*)d_ws;
    for (int i = 0; i < 32; ++i) a.inv[i] = (float)pow(10000.0, -(double)i / 32.0);
    for (int h = 0; h < 8; ++h) a.lg2g[h] = (float)log2(1.0 - exp2(-5.0 - (double)h));
    a.ph_lo = 0; a.ph_hi = 9; a.li = 0; a.pad = 7;
    hipLaunchKernelGGL(fwd, dim3(grid), dim3(NWAVES * 64), LDS_BYTES, stream, a);
}
```
